# Optimizing an MI355X kernel written in HIP

```python
import math
import jax, jax.numpy as jnp
from jax import lax
import numpy as np

D_MODEL = 1024
BATCH = 8
SEQ = 4096
DEPTH = 2

N_META = 16
BLOCK_Q = 128
EPS = 1e-6
MLA_HEADS = 8
MLA_Q_RANK = 384
MLA_KV_RANK = 256
MLA_NOPE = 64
MLA_ROPE = 32
MLA_V = 64
MLA_QK = MLA_NOPE + MLA_ROPE
MLA_SCALE = MLA_QK ** -0.5
ROPE_BASE = 10000.0
DSA_HEADS = 8
DSA_HEAD_DIM = 64
DSA_WIDTH = DSA_HEADS * DSA_HEAD_DIM
DSA_SCALE = DSA_HEAD_DIM ** -0.5
IDX_HEADS = 8
IDX_DIM = 32
DSA_TOPK_MAX = 256
REL_BUCKETS = 32
REL_MAX_DIST = 128
MIX_IN_SIZES = (MLA_Q_RANK, MLA_KV_RANK, MLA_ROPE, DSA_WIDTH, DSA_WIDTH, DSA_WIDTH,
                IDX_HEADS * IDX_DIM, IDX_DIM, IDX_HEADS)
MIX_IN = (MLA_Q_RANK + MLA_KV_RANK + MLA_ROPE + 3 * DSA_WIDTH
          + IDX_HEADS * IDX_DIM + IDX_DIM + IDX_HEADS)
MIX_OUT = MLA_HEADS * MLA_V + DSA_WIDTH
CONV_WIDTH = 3
CONV_DIM = D_MODEL
D_FF = 3584
N_EXPERTS = 8
TOP_K = 2
N_EVEN = (DEPTH + 1) // 2
N_ODD = DEPTH // 2

kernel_name = "hybrid_mla_dsa_shortconv_moe_block"


def rms_norm(x, g):
    xf = x.astype(jnp.float32)
    y = xf * lax.rsqrt(jnp.mean(xf * xf, axis=-1, keepdims=True) + EPS)
    return (y * g.astype(jnp.float32)).astype(x.dtype)


def rope(x, pos):
    half = MLA_ROPE // 2
    inv = ROPE_BASE ** (-jnp.arange(half, dtype=jnp.float32) / half)
    ang = pos.astype(jnp.float32)[:, None] * inv[None, :]
    cos = jnp.cos(ang)[:, None, :]
    sin = jnp.sin(ang)[:, None, :]
    x1 = x[..., :half].astype(jnp.float32)
    x2 = x[..., half:].astype(jnp.float32)
    return jnp.concatenate([x1 * cos - x2 * sin, x1 * sin + x2 * cos], axis=-1).astype(x.dtype)


def rel_bucket(dist):
    max_exact = REL_BUCKETS // 2
    d = jnp.maximum(dist, 0)
    df = jnp.maximum(d, 1).astype(jnp.float32)
    large = max_exact + (jnp.log(df / max_exact) / math.log(REL_MAX_DIST / max_exact)
                         * (REL_BUCKETS - max_exact)).astype(jnp.int32)
    large = jnp.minimum(large, REL_BUCKETS - 1)
    return jnp.where(d < max_exact, d, large)


def to_blocks(a, nb):
    a = a.reshape(a.shape[0], nb, BLOCK_Q, *a.shape[2:])
    return jnp.moveaxis(a, 1, 0)


def from_blocks(a):
    a = jnp.moveaxis(a, 0, 1)
    return a.reshape(a.shape[0], a.shape[1] * a.shape[2], *a.shape[3:])


def mla_heads(c_q, c_kv, k_rope, g_q_lat, g_kv_lat, w_uq, w_ukv, g_qn, g_kn, pos):
    b, lp, _ = c_q.shape
    q = (rms_norm(c_q, g_q_lat) @ w_uq).reshape(b, lp, MLA_HEADS, MLA_QK)
    kv = (rms_norm(c_kv, g_kv_lat) @ w_ukv).reshape(b, lp, MLA_HEADS, MLA_NOPE + MLA_V)
    k_rope_h = jnp.broadcast_to(k_rope[:, :, None, :], (b, lp, MLA_HEADS, MLA_ROPE))
    k = jnp.concatenate([kv[..., :MLA_NOPE], k_rope_h], axis=-1)
    v = kv[..., MLA_NOPE:]
    q = rms_norm(q, g_qn)
    k = rms_norm(k, g_kn)
    q = jnp.concatenate([q[..., :MLA_NOPE], rope(q[..., MLA_NOPE:], pos)], axis=-1)
    k = jnp.concatenate([k[..., :MLA_NOPE], rope(k[..., MLA_NOPE:], pos)], axis=-1)
    nb = lp // BLOCK_Q

    def attend(blk):
        qb, qpos = blk
        s = jnp.einsum("bqhd,bkhd->bhqk", qb, k).astype(jnp.float32) * MLA_SCALE
        s = jnp.where(pos[None, :] <= qpos[:, None], s, -jnp.inf)
        p = jax.nn.softmax(s, axis=-1).astype(v.dtype)
        return jnp.einsum("bhqk,bkhd->bqhd", p, v)

    o = lax.map(attend, (to_blocks(q, nb), pos.reshape(nb, BLOCK_Q)))
    return from_blocks(o).reshape(b, lp, MLA_HEADS * MLA_V)


def dsa_heads(q, k, v, q_idx, k_idx, w_idx, g_qn, g_kn, rel_bias, pos, n_keys):
    b, lp, _ = q.shape
    top_k = min(DSA_TOPK_MAX, n_keys // 4)
    q = rms_norm(q.reshape(b, lp, DSA_HEADS, DSA_HEAD_DIM), g_qn)
    k = rms_norm(k.reshape(b, lp, DSA_HEADS, DSA_HEAD_DIM), g_kn)
    kv = jnp.concatenate([k.reshape(b, lp, DSA_WIDTH), v], axis=-1)
    q_idx = q_idx.reshape(b, lp, IDX_HEADS, IDX_DIM)
    nb = lp // BLOCK_Q

    def attend(blk):
        qb, qib, wib, qpos = blk
        act = jax.nn.relu(jnp.einsum("bqhd,bkd->bqhk", qib, k_idx).astype(jnp.float32))
        score = jnp.einsum("bqh,bqhk->bqk", wib.astype(jnp.float32), act)
        score = jnp.where(pos[None, :] <= qpos[:, None], score, -jnp.inf)
        _, sel = lax.top_k(score, top_k)
        kv_sel = jax.vmap(lambda a, i: a[i])(kv, sel.reshape(b, BLOCK_Q * top_k))
        kv_sel = kv_sel.reshape(b, BLOCK_Q, top_k, 2, DSA_HEADS, DSA_HEAD_DIM)
        k_sel = kv_sel[:, :, :, 0]
        v_sel = kv_sel[:, :, :, 1]
        dist = qpos[None, :, None] - sel
        s = jnp.einsum("bqhd,bqkhd->bhqk", qb, k_sel).astype(jnp.float32) * DSA_SCALE
        s = s + jnp.transpose(rel_bias[rel_bucket(dist)], (0, 3, 1, 2)).astype(jnp.float32)
        s = jnp.where((dist >= 0)[:, None], s, -jnp.inf)
        p = jax.nn.softmax(s, axis=-1).astype(v_sel.dtype)
        return jnp.einsum("bhqk,bqkhd->bqhd", p, v_sel)

    o = lax.map(attend, (to_blocks(q, nb), to_blocks(q_idx, nb), to_blocks(w_idx, nb),
                         pos.reshape(nb, BLOCK_Q)))
    return from_blocks(o).reshape(b, lp, DSA_WIDTH)


def mla_dsa_mixer(h, w_mix_in, g_q_lat, g_kv_lat, w_uq, w_ukv, mla_qn, mla_kn,
                  dsa_qn, dsa_kn, rel_bias, w_mix_out, pos, n_keys):
    split_at = np.cumsum(MIX_IN_SIZES)[:-1].tolist()
    c_q, c_kv, k_rope, dq, dk, dv, iq, ik, iw = jnp.split(h @ w_mix_in, split_at, axis=-1)
    o_mla = mla_heads(c_q, c_kv, k_rope, g_q_lat, g_kv_lat, w_uq, w_ukv, mla_qn, mla_kn, pos)
    o_dsa = dsa_heads(dq, dk, dv, iq, ik, iw, dsa_qn, dsa_kn, rel_bias, pos, n_keys)
    return jnp.concatenate([o_mla, o_dsa], axis=-1) @ w_mix_out


def short_conv_mixer(h, w_in, conv_w, w_out):
    b_gate, c_gate, u = jnp.split(h @ w_in, 3, axis=-1)
    z = c_gate * u
    y = lax.conv_general_dilated(z, conv_w.astype(z.dtype), window_strides=(1,),
                                 padding=[(CONV_WIDTH - 1, 0)],
                                 dimension_numbers=("NWC", "WIO", "NWC"),
                                 feature_group_count=CONV_DIM)
    return (b_gate * y) @ w_out


def swiglu(h, w1, w3, w2):
    return (jax.nn.silu(h @ w1) * (h @ w3)) @ w2


def moe_swiglu(h, w_router, w1, w3, w2):
    logits = (h @ w_router).astype(jnp.float32)
    top_val, top_idx = lax.top_k(logits, TOP_K)
    gates = jax.nn.softmax(top_val, axis=-1)
    gate_dense = jnp.sum(jax.nn.one_hot(top_idx, N_EXPERTS, dtype=jnp.float32)
                         * gates[..., None], axis=-2).astype(h.dtype)
    out = jnp.zeros_like(h)
    for e in range(N_EXPERTS):
        out = out + gate_dense[..., e:e + 1] * swiglu(h, w1[e], w3[e], w2[e])
    return out


def setup_inputs(seed: int = 0) -> dict:
    key = jax.random.key(seed)
    keys = jax.random.split(key, 40)
    ctr = [0]

    def nxt():
        k = keys[ctr[0]]
        ctr[0] += 1
        return k

    def w(shape, fan_in):
        return jax.random.normal(nxt(), shape, jnp.float32) * (fan_in ** -0.5)

    def gain(shape):
        return 1.0 + 0.02 * jax.random.normal(nxt(), shape, jnp.float32)

    NE, NO = N_EVEN, N_ODD
    return {
        "x": jax.random.normal(nxt(), (BATCH, SEQ, D_MODEL), jnp.float32),
        "meta_tokens": jax.random.normal(nxt(), (N_META, D_MODEL), jnp.float32),
        "rel_bias": 0.5 * jax.random.normal(nxt(), (REL_BUCKETS, DSA_HEADS), jnp.float32),
        "ev_norm_mix": gain((NE, D_MODEL)),
        "ev_w_mix_in": w((NE, D_MODEL, MIX_IN), D_MODEL),
        "ev_g_q_lat": gain((NE, MLA_Q_RANK)),
        "ev_g_kv_lat": gain((NE, MLA_KV_RANK)),
        "ev_w_uq": w((NE, MLA_Q_RANK, MLA_HEADS * MLA_QK), MLA_Q_RANK),
        "ev_w_ukv": w((NE, MLA_KV_RANK, MLA_HEADS * (MLA_NOPE + MLA_V)), MLA_KV_RANK),
        "ev_mla_q_norm": gain((NE, MLA_QK)),
        "ev_mla_k_norm": gain((NE, MLA_QK)),
        "ev_dsa_q_norm": gain((NE, DSA_HEAD_DIM)),
        "ev_dsa_k_norm": gain((NE, DSA_HEAD_DIM)),
        "ev_w_mix_out": w((NE, MIX_OUT, D_MODEL), MIX_OUT),
        "ev_norm_ffn": gain((NE, D_MODEL)),
        "ev_w1": w((NE, D_MODEL, D_FF), D_MODEL),
        "ev_w3": w((NE, D_MODEL, D_FF), D_MODEL),
        "ev_w2": w((NE, D_FF, D_MODEL), D_FF),
        "od_norm_mix": gain((NO, D_MODEL)),
        "od_w_in": w((NO, D_MODEL, 3 * CONV_DIM), D_MODEL),
        "od_conv_w": w((NO, CONV_WIDTH, 1, CONV_DIM), CONV_WIDTH),
        "od_w_out": w((NO, CONV_DIM, D_MODEL), CONV_DIM),
        "od_norm_ffn": gain((NO, D_MODEL)),
        "od_w_router": w((NO, D_MODEL, N_EXPERTS), D_MODEL),
        "od_w1": w((NO, N_EXPERTS, D_MODEL, D_FF), D_MODEL),
        "od_w3": w((NO, N_EXPERTS, D_MODEL, D_FF), D_MODEL),
        "od_w2": w((NO, N_EXPERTS, D_FF, D_MODEL), D_FF),
    }


def reference(x, meta_tokens, rel_bias,
              ev_norm_mix, ev_w_mix_in, ev_g_q_lat, ev_g_kv_lat, ev_w_uq, ev_w_ukv,
              ev_mla_q_norm, ev_mla_k_norm, ev_dsa_q_norm, ev_dsa_k_norm, ev_w_mix_out,
              ev_norm_ffn, ev_w1, ev_w3, ev_w2,
              od_norm_mix, od_w_in, od_conv_w, od_w_out,
              od_norm_ffn, od_w_router, od_w1, od_w3, od_w2):
    b, seq, d = x.shape
    l_tot = seq + N_META
    lp = -(-l_tot // BLOCK_Q) * BLOCK_Q
    meta = jnp.broadcast_to(meta_tokens[None].astype(x.dtype), (b, N_META, d))
    h = jnp.concatenate([meta, x, jnp.zeros((b, lp - l_tot, d), x.dtype)], axis=1)
    pos = jnp.arange(lp, dtype=jnp.int32)
    for layer in range(DEPTH):
        i = layer // 2
        if layer % 2 == 0:
            h = h + mla_dsa_mixer(rms_norm(h, ev_norm_mix[i]), ev_w_mix_in[i], ev_g_q_lat[i],
                                  ev_g_kv_lat[i], ev_w_uq[i], ev_w_ukv[i], ev_mla_q_norm[i],
                                  ev_mla_k_norm[i], ev_dsa_q_norm[i], ev_dsa_k_norm[i],
                                  rel_bias, ev_w_mix_out[i], pos, l_tot)
            h = h + swiglu(rms_norm(h, ev_norm_ffn[i]), ev_w1[i], ev_w3[i], ev_w2[i])
        else:
            h = h + short_conv_mixer(rms_norm(h, od_norm_mix[i]), od_w_in[i], od_conv_w[i],
                                     od_w_out[i])
            h = h + moe_swiglu(rms_norm(h, od_norm_ffn[i]), od_w_router[i], od_w1[i],
                               od_w3[i], od_w2[i])
    return h[:, N_META:l_tot]
```

```cpp
#include <hip/hip_runtime.h>
#include <cstdio>
#include <cstdint>

#ifndef NAIVE_ATTN
#define NAIVE_ATTN 0
#endif
#ifndef MK_ONE_LAUNCH
#define MK_ONE_LAUNCH 1
#endif

#define GAS __attribute__((address_space(1)))
#define LAS __attribute__((address_space(3)))
typedef unsigned short bf16_t;
typedef unsigned v4u __attribute__((ext_vector_type(4)));
typedef unsigned v2u __attribute__((ext_vector_type(2)));
typedef float f32x4 __attribute__((ext_vector_type(4)));
typedef GAS unsigned gu32;
#define RLX_AGENT __ATOMIC_RELAXED, __HIP_MEMORY_SCOPE_AGENT
#define DI __device__ __forceinline__

constexpr int NB = 8, SEQ = 4096, D = 1024, NMETA = 16, LTOT = SEQ + NMETA, LP = 4224, MP = NB * LP, MR = NB * SEQ;
constexpr int DFF = 3584, NE = 8;
constexpr int QR = 384, KVR = 256, MQK = 96, MLAW = 768;
constexpr int DW = 512, TOPK = 256;
constexpr int MIXIN = 2504, MIXN = 2560;
constexpr float EPS = 1e-6f;
constexpr float LOG2E = 1.4426950408889634f;
constexpr float MLA_QS = 0.10206207261596577f * LOG2E;
constexpr float DSA_QS = 0.125f * LOG2E;
constexpr int MOE_ROWS = 34816;

constexpr size_t MiB = 1u << 20;
constexpr size_t WS_CTL = 0, CTL_ZERO_BYTES = 1 * MiB;
constexpr size_t WS_TAB = 1 * MiB;
constexpr size_t TAB_LUT = WS_TAB;
constexpr size_t TAB_ROWTOK = WS_TAB + 64 * 1024;
constexpr size_t TAB_ROWGATE = TAB_ROWTOK + 2 * MOE_ROWS * 4;
constexpr size_t TAB_ASG = TAB_ROWGATE + 2 * MOE_ROWS * 4;
constexpr size_t TAB_GATE = TAB_ASG + 2 * MR * 4;
static_assert(TAB_GATE + 2 * MR * 4 <= 4 * MiB, "tables");
constexpr size_t WS_MASK = 480 * MiB;
constexpr size_t WS_PART_A = 240 * MiB, WS_PART_F = 471 * MiB, WS_PART_M = 4 * MiB;
constexpr int CAP_A = 128, CAP_F = 160, CAP_M = 152;
constexpr size_t WS_WMIX = 4 * MiB, WS_WUQ = 9 * MiB, WS_WUKV = 10 * MiB, WS_WMO = 11 * MiB, WS_W13 = 13 * MiB, WS_W2 = 27 * MiB, WS_WIN = 34 * MiB, WS_WOUT = 40 * MiB;
constexpr size_t WS_H = 42 * MiB;
constexpr size_t WS_XN = 174 * MiB;
constexpr size_t WS_LAT = 240 * MiB;
constexpr size_t WS_DQ = 290 * MiB, WS_DK = 323 * MiB, WS_DV = 356 * MiB;
constexpr size_t WS_IQ = 389 * MiB;
constexpr size_t WS_KR = 406 * MiB, WS_IK = 409 * MiB, WS_IW = 412 * MiB;
constexpr size_t WS_IWC = 412 * MiB;
constexpr size_t WS_IKC = 409 * MiB;
constexpr size_t WS_SSP = 406 * MiB;
constexpr size_t WS_VMT = 414 * MiB, WS_VDT = 447 * MiB;
constexpr size_t WS_HF = 240 * MiB;
constexpr size_t WS_Z = 240 * MiB;
constexpr size_t WS_MW13 = 108 * MiB, WS_MW2 = 438 * MiB;
constexpr size_t WS_XN2 = 405 * MiB;
constexpr size_t WS_PARTA = 42 * MiB;
constexpr size_t WS_H3B = 341 * MiB;
constexpr size_t WS_HM = 222 * MiB;
constexpr size_t WS_END = 512 * MiB;
static_assert(WS_H + (size_t)MP * D * 2 <= WS_MW13 && WS_PARTA + (size_t)MR * D * 2 <= WS_MW13 && WS_MW13 + (size_t)NE * 2 * DFF * D <= WS_XN && WS_HM + (size_t)MOE_ROWS * DFF <= WS_H3B && WS_H3B + (size_t)MR * D * 2 <= WS_XN2 && WS_XN2 + (size_t)MR * D <= WS_MW2 && WS_Z + (size_t)MP * 2048 * 2 <= WS_MW2 && WS_MW2 + (size_t)NE * DFF * D <= WS_END && WS_XN + (size_t)MP * D * 2 <= WS_H3B && WS_PART_M + (size_t)CAP_M * 262144 <= WS_PARTA, "ws map");
static_assert(WS_HF + (size_t)MP * DFF * 2 <= WS_END, "ws map");
constexpr size_t OUT_KV = 0, OUT_QM = 66 * MiB;

constexpr int CW_TMO = 0, CW_CNT = 64  , CW_BAR = 4096;

constexpr int WSCR = 18048;
constexpr int LDS_BYTES = 147456;
constexpr int MISC_OFF = LDS_BYTES - 128;
constexpr int RING_BYTES = 131072, GTAB_OFF = RING_BYTES, GTAB_SLOTS = 15;
static_assert(8 * WSCR <= MISC_OFF && GTAB_OFF + GTAB_SLOTS * 1024 <= MISC_OFF, "lds");

DI float bf2f(bf16_t x) { return __uint_as_float(((unsigned)x) << 16); }
DI unsigned f2bf(float f) { unsigned u = __float_as_uint(f); return (u + 0x7fffu + ((u >> 16) & 1u)) >> 16; }
typedef float f32x2_t __attribute__((ext_vector_type(2))); typedef __bf16 bf16x2_t __attribute__((ext_vector_type(2)));
DI unsigned pk2(float lo, float hi) { f32x2_t v = {lo, hi}; bf16x2_t b = __builtin_convertvector(v, bf16x2_t); return __builtin_bit_cast(unsigned, b); }
DI float lo2f(unsigned w) { return __uint_as_float(w << 16); }
DI float hi2f(unsigned w) { return __uint_as_float(w & 0xffff0000u); }
DI float wave_sum(float v) {
    v += __builtin_bit_cast(float, __builtin_amdgcn_update_dpp(0, __builtin_bit_cast(int, v), 0xB1, 0xf, 0xf, true));
    v += __builtin_bit_cast(float, __builtin_amdgcn_update_dpp(0, __builtin_bit_cast(int, v), 0x4E, 0xf, 0xf, true));
    v += __builtin_bit_cast(float, __builtin_amdgcn_update_dpp(0, __builtin_bit_cast(int, v), 0x141, 0xf, 0xf, true));
    v += __builtin_bit_cast(float, __builtin_amdgcn_update_dpp(0, __builtin_bit_cast(int, v), 0x140, 0xf, 0xf, true));
    const int iv = __builtin_bit_cast(int, v);
    return (__builtin_bit_cast(float, __builtin_amdgcn_readlane(iv, 0)) + __builtin_bit_cast(float, __builtin_amdgcn_readlane(iv, 16)))
         + (__builtin_bit_cast(float, __builtin_amdgcn_readlane(iv, 32)) + __builtin_bit_cast(float, __builtin_amdgcn_readlane(iv, 48)));
}
DI float wave_max(float v) {
#pragma unroll
    for (int o = 1; o < 64; o <<= 1) v = fmaxf(v, __shfl_xor(v, o));
    return v;
}
DI void unpack8(v4u w, float (&f)[8]) { f[0] = lo2f(w.x); f[1] = hi2f(w.x); f[2] = lo2f(w.y); f[3] = hi2f(w.y); f[4] = lo2f(w.z); f[5] = hi2f(w.z); f[6] = lo2f(w.w); f[7] = hi2f(w.w); }
DI v4u pack8(const float (&f)[8]) { v4u w; w.x = pk2(f[0], f[1]); w.y = pk2(f[2], f[3]); w.z = pk2(f[4], f[5]); w.w = pk2(f[6], f[7]); return w; }

#define XB_TMO      128
#define XB_XCNT(j)  (256  + 64 * (j))
#define XB_XSUB(j)  (1280 + 64 * (j))
#define XB_XGEN(j)  (2304 + 64 * (j))
#define XB_TOP      3328
#define XB_TOPGEN   3392
#define XCD_BAR_WORDS 3456
#define XB_SPIN_CAP (1u << 22)
DI unsigned xb_ld(unsigned* p)              { return __hip_atomic_load(p, __ATOMIC_RELAXED, __HIP_MEMORY_SCOPE_AGENT); }
DI unsigned xb_add(unsigned* p, unsigned v) { return __hip_atomic_fetch_add(p, v, __ATOMIC_RELAXED, __HIP_MEMORY_SCOPE_AGENT); }
DI unsigned xb_xcc_id() { return (unsigned)__builtin_amdgcn_s_getreg((3 << 11) | 20) & 0xFu; }
#define XB_SPIN(cond, bar) do { unsigned _sp = 0; while (cond) { __builtin_amdgcn_s_sleep(1); \
    if ((++_sp & 255u) == 0u) { if (xb_ld(&(bar)[XB_TMO])) break; if (_sp > XB_SPIN_CAP) { atomicAdd(&(bar)[XB_TMO], 1u); break; } } } } while (0)
struct XcdBarrier { unsigned* bar; unsigned x; volatile LAS unsigned* st; };
DI XcdBarrier xcd_barrier_post(unsigned* bar, volatile LAS unsigned* st) {
    XcdBarrier b; b.bar = bar; b.x = xb_xcc_id(); b.st = st;
    if (threadIdx.x == 0) (void)xb_add(&bar[XB_XCNT(b.x)], 1u);
    return b;
}
DI void xcd_barrier_complete(unsigned* bar, unsigned x, unsigned& nloc, unsigned& nx) {
    const unsigned G = gridDim.x * gridDim.y * gridDim.z;
    unsigned sum, cnt, mine, sp = 0u;
    for (;;) {
        sum = 0u; cnt = 0u; mine = 0u;
#pragma unroll
        for (unsigned j = 0; j < 16; ++j) { const unsigned c = xb_ld(&bar[XB_XCNT(j)]); sum += c; cnt += (c > 0u) ? 1u : 0u; mine = (j == x) ? c : mine; }
        if (sum == G) break;
        __builtin_amdgcn_s_sleep(1);
        if ((++sp & 255u) == 0u) { if (xb_ld(&bar[XB_TMO])) break; if (sp > XB_SPIN_CAP) { atomicAdd(&bar[XB_TMO], 1u); break; } }
    }
    nloc = mine > 0u ? mine : 1u; nx = cnt > 0u ? cnt : 1u;
}
DI void xcd_barrier(const XcdBarrier& b) {
    asm volatile("s_waitcnt vmcnt(0)" ::: "memory");
    __syncthreads();
    if (threadIdx.x == 0) {
        unsigned* bar = b.bar;
        __builtin_amdgcn_s_waitcnt(0);
        unsigned nloc = b.st[0], nx = b.st[1];
        if (nloc == 0u) { xcd_barrier_complete(bar, b.x, nloc, nx); b.st[0] = nloc; b.st[1] = nx; }
        const unsigned old = xb_add(&bar[XB_XSUB(b.x)], 1u);
        const unsigned gen = old / nloc;
        if (old + 1u == (gen + 1u) * nloc) {
            __builtin_amdgcn_fence(__ATOMIC_RELEASE, "agent");
            asm volatile("s_waitcnt vmcnt(0)" ::: "memory");
            const unsigned og = xb_add(&bar[XB_TOP], 1u);
            const unsigned tg = og / nx;
            if (og + 1u == (tg + 1u) * nx) xb_add(&bar[XB_TOPGEN], 1u);
            else XB_SPIN(xb_ld(&bar[XB_TOPGEN]) == tg, bar);
            __builtin_amdgcn_fence(__ATOMIC_ACQUIRE, "agent");
            xb_add(&bar[XB_XGEN(b.x)], 1u);
            asm volatile("s_waitcnt vmcnt(0)" ::: "memory");
        } else {
            XB_SPIN(xb_ld(&bar[XB_XGEN(b.x)]) == gen, bar);
            __builtin_amdgcn_fence(__ATOMIC_ACQUIRE, "agent");
            asm volatile("s_waitcnt vmcnt(0)" ::: "memory");
        }
    }
    __syncthreads();
}

struct Args { const float* in[27]; float* out; unsigned char* ws; int ph_lo, ph_hi; };
struct Ctx {
    int tid, lane, wave, gw, ngw, G, bid;
    unsigned char* lds;
    unsigned char* wscr;
};

struct Unit { int pm, pn; const bf16_t* Bt; int koff, nt, atomic; };
struct GemmP { const bf16_t* A; int lda; const int* arow; int ldb; int K; };

DI int pick_split(int tail, int cap, int k128) {
    const int cand[6] = {28, 14, 8, 7, 4, 2};
    int S = 1;
#pragma unroll
    for (int i = 5; i >= 0; --i) if (k128 % cand[i] == 0 && tail * cand[i] <= cap) S = cand[i];
    return S;
}
struct StaticSched {
    int nM, nN, nwg, G, c, full, S, ntf, nts; const bf16_t* Bt;
    DI void init(int nM_, int nN_, int G_, int c_, const bf16_t* Bt_, int K, int cap) {
        nM = nM_; nN = nN_; nwg = nM * nN; G = G_; c = c_; Bt = Bt_; ntf = K / 64; full = nwg; S = 1; nts = ntf;
        if (cap > 0) { full = (nwg / G) * G; const int tail = nwg - full; if (tail > 0) { S = pick_split(tail, cap < G ? cap : G, K / 128); nts = ntf / S; } if (S == 1) full = nwg; }
    }
    DI bool next(int i, Unit& u) const {
        const int L = i * G + c; int wgid;
        if (L < full) { wgid = L; u.koff = 0; u.nt = ntf; u.atomic = 0; }
        else { const int r = L - full; if (r >= (nwg - full) * S) return false; wgid = full + r / S; u.koff = (r % S) * nts * 64; u.nt = nts; u.atomic = r + 1; }
        { const int q = nwg / 8, r = nwg % 8, xcd = wgid % 8, off = wgid / 8; wgid = (xcd < r ? xcd * (q + 1) : r * (q + 1) + (xcd - r) * q) + off; }
        const int nig = 8 * nN, gid = wgid / nig, fm = gid * 8, gsz = (nM - fm) < 8 ? (nM - fm) : 8;
        u.pm = fm + ((wgid % nig) % gsz); u.pn = (wgid % nig) / gsz; u.Bt = Bt; return true;
    }
    DI int index_of(int pm, int pn) const {
        const int nig = 8 * nN, gid = pm / 8, fm = gid * 8, gsz = (nM - fm) < 8 ? (nM - fm) : 8;
        const int w = gid * nig + pn * gsz + (pm - fm);
        const int q = nwg / 8, r = nwg % 8; int xcd, off;
        if (w < r * (q + 1)) { xcd = w / (q + 1); off = w % (q + 1); } else { const int w2 = w - r * (q + 1); xcd = r + w2 / q; off = w2 % q; }
        return off * 8 + xcd;
    }
};
template <int NN>
struct MoeSched {
    int tiles[NE]; int nM, G, c, full, S, ntf, nts; const bf16_t* Bt; size_t estride;
    DI void init(const unsigned* cnt, int G_, int c_, const bf16_t* Bt_, size_t estride_, int K, int cap) {
        nM = 0;
#pragma unroll
        for (int e = 0; e < NE; ++e) { tiles[e] = __builtin_amdgcn_readfirstlane((int)((__hip_atomic_load(cnt + e, RLX_AGENT) + 255u) >> 8)); nM += tiles[e]; }
        G = G_; c = c_; Bt = Bt_; estride = estride_; ntf = K / 64; const int nwg = nM * NN; full = nwg; S = 1; nts = ntf;
        if (cap > 0) { full = (nwg / G) * G; const int tail = nwg - full; if (tail > 0) { S = pick_split(tail, cap < G ? cap : G, K / 128); nts = ntf / S; } if (S == 1) full = nwg; }
    }
    DI bool next(int i, Unit& u) const {
        const int L = i * G + c, nwg = nM * NN; int id;
        if (L < full) { id = L; u.koff = 0; u.nt = ntf; u.atomic = 0; }
        else { const int r = L - full; if (r >= (nwg - full) * S) return false; id = full + r / S; u.koff = (r % S) * nts * 64; u.nt = nts; u.atomic = r + 1; }
        u.pm = id / NN; u.pn = id % NN;
        int e = 0, acc = 0;
#pragma unroll
        for (int k = 0; k < NE; ++k) { acc += tiles[k]; if (u.pm >= acc) e = k + 1; }
        if (e > NE - 1) e = NE - 1;
        u.Bt = Bt + (size_t)e * estride; return true;
    }
};

DI void st8bf(bf16_t* p, const float (&v)[8]) { *(v4u*)p = pack8(v); }
struct EpiRoute {
    unsigned char* ws; const float* g_dq; const float* g_dk;
    DI void elem8(int row, int pn, int c0, const float (&v0)[8], const float (&v1)[8], int) const {
        if (pn >= 3 && pn < 7) {
            const int isk = pn >= 5, wc = c0 >> 5, fq8 = c0 & 31, head = ((pn - 3) & 1) * 4 + wc;
            float ss = 0.f;
#pragma unroll
            for (int j = 0; j < 8; ++j) ss += v0[j] * v0[j] + v1[j] * v1[j];
            ss += __shfl_xor(ss, 16); ss += __shfl_xor(ss, 32);
            const float rstd = 1.0f / sqrtf(ss * (1.f / 64.f) + EPS) * (isk ? 1.f : DSA_QS);
            const float* g = (isk ? g_dk : g_dq) + fq8;
            float a[8], bq[8];
#pragma unroll
            for (int j = 0; j < 8; ++j) { a[j] = v0[j] * rstd * g[j]; bq[j] = v1[j] * rstd * g[32 + j]; }
            bf16_t* p = (bf16_t*)(ws + (isk ? WS_DK : WS_DQ)) + (size_t)row * 512 + head * 64 + fq8; st8bf(p, a); st8bf(p + 32, bq);
            return;
        }
        size_t off; int ld, col;
        if (pn < 3) { off = WS_LAT; ld = 768; col = pn * 256;
            float ss = 0.f;
#pragma unroll
            for (int j = 0; j < 8; ++j) ss += v0[j] * v0[j] + (pn < 2 ? v1[j] * v1[j] : 0.f);
            ss += __shfl_xor(ss, 16); ss += __shfl_xor(ss, 32);
            if ((c0 & 31) == 0) ((float*)(ws + WS_SSP))[(size_t)row * 12 + pn * 4 + (c0 >> 5)] = ss; }
        else if (pn < 9) { off = WS_DV; ld = 512; col = (pn - 7) * 256; }
        else { off = WS_IQ; ld = 256; col = 0; }
        bf16_t* p = (bf16_t*)(ws + off) + (size_t)row * ld + col + c0; st8bf(p, v0); st8bf(p + 128, v1);
        if (pn == 2 && c0 == 64) st8bf((bf16_t*)(ws + WS_IWC) + (size_t)row * 8, v1);
        if (pn == 2 && (c0 >> 5) == 1) { const int bb = row / LP, tt = row - bb * LP; st8bf((bf16_t*)(ws + WS_IKC) + ((size_t)(bb * 4 + ((c0 >> 3) & 3)) * LP + tt) * 8, v1); }
    }
};
struct EpiUp {
    bf16_t* O; int ld; const float* ssp; int isq;
    DI void elem8(int row, int pn, int c0, const float (&v0)[8], const float (&v1)[8], int) const {
        const f32x4* sp = (const f32x4*)(ssp + (size_t)row * 12);
        float rstd;
        if (isq) { const f32x4 a = sp[1], b = sp[2]; rstd = 1.0f / sqrtf((((a.x + a.y) + (a.z + a.w)) + ((b.x + b.y) + (b.z + b.w))) * (1.f / QR) + EPS); }
        else { const f32x4 a = sp[0]; rstd = 1.0f / sqrtf(((a.x + a.y) + (a.z + a.w)) * (1.f / KVR) + EPS); }
        float a[8], bq[8];
#pragma unroll
        for (int j = 0; j < 8; ++j) { a[j] = v0[j] * rstd; bq[j] = v1[j] * rstd; }
        bf16_t* p = O + (size_t)row * ld + pn * 256 + c0; st8bf(p, a); st8bf(p + 128, bq);
    }
};
struct EpiBf16 {
    bf16_t* O; int ld;
    DI void elem8(int row, int pn, int c0, const float (&v0)[8], const float (&v1)[8], int atomic) const { bf16_t* p = O + (size_t)row * ld + pn * 256 + c0; st8bf(p, v0); st8bf(p + 128, v1); }
};
DI unsigned pk4f8(float a, float b, float c2, float d) {
    a = __builtin_amdgcn_fmed3f(a, -448.f, 448.f); b = __builtin_amdgcn_fmed3f(b, -448.f, 448.f); c2 = __builtin_amdgcn_fmed3f(c2, -448.f, 448.f); d = __builtin_amdgcn_fmed3f(d, -448.f, 448.f);
    int w = 0; w = __builtin_amdgcn_cvt_pk_fp8_f32(a, b, w, false); w = __builtin_amdgcn_cvt_pk_fp8_f32(c2, d, w, true); return (unsigned)w;
}
constexpr float F8_SX = 4.f, F8_SW1 = 64.f, F8_SH = 8.f, F8_SW2 = 128.f;
struct EpiGlu8 {
    unsigned char* H; int ld;
    DI void elem8(int row, int pn, int c0, const float (&v0)[8], const float (&v1)[8], int atomic) const {
        constexpr float inv = 1.f / (F8_SX * F8_SW1);
        float o[8];
#pragma unroll
        for (int j = 0; j < 8; j += 2) {
            const f32x2_t x = (f32x2_t){v0[j], v0[j + 1]} * (f32x2_t){inv, inv}, y = (f32x2_t){v1[j], v1[j + 1]} * (f32x2_t){inv * F8_SH, inv * F8_SH}; const f32x2_t t = x * (f32x2_t){-LOG2E, -LOG2E};
            const f32x2_t d = (f32x2_t){__builtin_amdgcn_exp2f(t.x), __builtin_amdgcn_exp2f(t.y)} + (f32x2_t){1.f, 1.f};
            const f32x2_t r = {__builtin_amdgcn_rcpf(d.x), __builtin_amdgcn_rcpf(d.y)}; const f32x2_t q = (x * r) * y; o[j] = q.x; o[j + 1] = q.y; }
        v2u w; w.x = pk4f8(o[0], o[1], o[2], o[3]); w.y = pk4f8(o[4], o[5], o[6], o[7]);
        *(v2u*)(H + (size_t)row * ld + pn * 128 + c0) = w;
    }
};
struct EpiConvIn {
    bf16_t* Z2;
    DI void elem8(int row, int pn, int c0, const float (&v0)[8], const float (&v1)[8], int atomic) const {
        bf16_t* p = Z2 + (size_t)row * 2048;
        if (pn < 8) { float o[8];
#pragma unroll
            for (int j = 0; j < 8; ++j) o[j] = v0[j] * v1[j];
            st8bf(p + pn * 128 + c0, o); }
        else { p += 1024 + (pn - 8) * 256 + c0; st8bf(p, v0); st8bf(p + 128, v1); }
    }
};
struct EpiGlu {
    bf16_t* H; int ld;
    DI void elem8(int row, int pn, int c0, const float (&v0)[8], const float (&v1)[8], int atomic) const {
        float o[8];
#pragma unroll
        for (int j = 0; j < 8; j += 2) {
            const f32x2_t x = {v0[j], v0[j + 1]}, y = {v1[j], v1[j + 1]}; const f32x2_t t = x * (f32x2_t){-LOG2E, -LOG2E};
            const f32x2_t d = (f32x2_t){__builtin_amdgcn_exp2f(t.x), __builtin_amdgcn_exp2f(t.y)} + (f32x2_t){1.f, 1.f};
            const f32x2_t r = {__builtin_amdgcn_rcpf(d.x), __builtin_amdgcn_rcpf(d.y)}; const f32x2_t q = (x * r) * y; o[j] = q.x; o[j + 1] = q.y; }
        st8bf(H + (size_t)row * ld + pn * 128 + c0, o);
    }
};
DI void st8f(float* p, const float (&v)[8]) { *(f32x4*)p = (f32x4){v[0], v[1], v[2], v[3]}; *(f32x4*)(p + 4) = (f32x4){v[4], v[5], v[6], v[7]}; }
DI void part_store(float* part, int slab, int row, int c0, const float (&v0)[8], const float (&v1)[8]) {
    const __amdgpu_buffer_rsrc_t rsrc = __builtin_amdgcn_make_buffer_rsrc((void*)part, 0, 0x40000000, 0x00020000);
    const unsigned off = (unsigned)slab * 262144u + (unsigned)(((row & 255) * 256 + c0) * 4);
    __builtin_amdgcn_raw_buffer_store_b128((v4u){__float_as_uint(v0[0]), __float_as_uint(v0[1]), __float_as_uint(v0[2]), __float_as_uint(v0[3])}, rsrc, off, 0, 0);
    __builtin_amdgcn_raw_buffer_store_b128((v4u){__float_as_uint(v0[4]), __float_as_uint(v0[5]), __float_as_uint(v0[6]), __float_as_uint(v0[7])}, rsrc, off + 16u, 0, 0);
    __builtin_amdgcn_raw_buffer_store_b128((v4u){__float_as_uint(v1[0]), __float_as_uint(v1[1]), __float_as_uint(v1[2]), __float_as_uint(v1[3])}, rsrc, off + 512u, 0, 0);
    __builtin_amdgcn_raw_buffer_store_b128((v4u){__float_as_uint(v1[4]), __float_as_uint(v1[5]), __float_as_uint(v1[6]), __float_as_uint(v1[7])}, rsrc, off + 528u, 0, 0);
}
struct EpiResid {
    const bf16_t* base; bf16_t* out; int real; float* part;
    DI void elem8(int row, int pn, int c0, const float (&v0)[8], const float (&v1)[8], int atomic) const {
        if (atomic) { part_store(part, atomic - 1, row, c0, v0, v1); return; }
        const int brow = real ? ((row >> 12) * LP + NMETA + (row & 4095)) : row;
        const bf16_t* bp = base + (size_t)brow * D + pn * 256 + c0;
        float a[8], b[8]; unpack8(*(const v4u*)bp, a); unpack8(*(const v4u*)(bp + 128), b);
#pragma unroll
        for (int j = 0; j < 8; ++j) { a[j] += v0[j]; b[j] += v1[j]; }
        bf16_t* op = out + (size_t)row * D + pn * 256 + c0; st8bf(op, a); st8bf(op + 128, b);
    }
};
template <int SLOT>
struct EpiMoe2 {
    const int* rowtok; const float* rowgate; float* out; float* part; float sc; bf16_t* parta; const bf16_t* h3;
    DI void elem8(int row, int pn, int c0, const float (&v0)[8], const float (&v1)[8], int atomic) const {
        if (atomic) { part_store(part, atomic - 1, row, c0, v0, v1); return; }
        const int tok = rowtok[row]; if (tok < 0) return; const float g = rowgate[row] * sc;
        const __amdgpu_buffer_rsrc_t rp = __builtin_amdgcn_make_buffer_rsrc((void*)parta, 0, 0x04000000, 0x00020000);
        const unsigned offb = (unsigned)tok * (unsigned)(D * 2) + (unsigned)((pn * 256 + c0) * 2);
        float a[8], b[8];
#pragma unroll
        for (int j = 0; j < 8; ++j) { a[j] = v0[j] * g; b[j] = v1[j] * g; }
        if constexpr (SLOT == 0) {
            __builtin_amdgcn_raw_buffer_store_b128(pack8(a), rp, offb, 0, 0); __builtin_amdgcn_raw_buffer_store_b128(pack8(b), rp, offb + 256u, 0, 0);
        } else {
            const __amdgpu_buffer_rsrc_t rh = __builtin_amdgcn_make_buffer_rsrc((void*)h3, 0, 0x04000000, 0x00020000);
            const __amdgpu_buffer_rsrc_t ro = __builtin_amdgcn_make_buffer_rsrc((void*)out, 0, 0x08000000, 0x00020000);
            const v4u pa = __builtin_amdgcn_raw_buffer_load_b128(rp, offb, 0, 0), pb = __builtin_amdgcn_raw_buffer_load_b128(rp, offb + 256u, 0, 0);
            const v4u ha = __builtin_amdgcn_raw_buffer_load_b128(rh, offb, 0, 0), hb = __builtin_amdgcn_raw_buffer_load_b128(rh, offb + 256u, 0, 0);
            float t[8], u[8];
            unpack8(pa, t); unpack8(ha, u);
#pragma unroll
            for (int j = 0; j < 8; ++j) a[j] += t[j] + u[j];
            unpack8(pb, t); unpack8(hb, u);
#pragma unroll
            for (int j = 0; j < 8; ++j) b[j] += t[j] + u[j];
            const unsigned off = 2u * offb;
#define MOE2_V4(X_, j0) (v4u){__float_as_uint(X_[j0]), __float_as_uint(X_[j0 + 1]), __float_as_uint(X_[j0 + 2]), __float_as_uint(X_[j0 + 3])}
            __builtin_amdgcn_raw_buffer_store_b128(MOE2_V4(a, 0), ro, off, 0, 0); __builtin_amdgcn_raw_buffer_store_b128(MOE2_V4(a, 4), ro, off + 16u, 0, 0);
            __builtin_amdgcn_raw_buffer_store_b128(MOE2_V4(b, 0), ro, off + 512u, 0, 0); __builtin_amdgcn_raw_buffer_store_b128(MOE2_V4(b, 4), ro, off + 528u, 0, 0);
#undef MOE2_V4
        }
    }
};

template <class Epi, class Sched>
DI void gemm_phase_naive(const Ctx& c, const GemmP g, const Sched& S, const Epi& E) {
    float* As = (float*)c.lds;
    float* Bs = (float*)(c.lds + 32 * 132 * 4);
    const int tid = c.tid, ty = tid >> 4, tx = tid & 15;
    Unit u;
    for (int i = 0; S.next(i, u); ++i) {
        for (int half = 0; half < 2; ++half) {
            float acc0[4][8], acc1[4][8];
#pragma unroll
            for (int a = 0; a < 4; ++a)
#pragma unroll
                for (int j = 0; j < 8; ++j) { acc0[a][j] = 0.f; acc1[a][j] = 0.f; }
            const int rbase = u.pm * 256 + half * 128;
            const int ar = tid >> 2, ak = (tid & 3) * 8;
            int arow_g = g.arow ? g.arow[rbase + ar] : (rbase + ar); if (arow_g < 0) arow_g = 0;
            const bf16_t* ap = g.A + (size_t)arow_g * g.lda + ak + u.koff;
            const int bn = tid >> 1, bk = (tid & 1) * 16;
            const bf16_t* bp = u.Bt + (size_t)(u.pn * 256 + bn) * g.ldb + bk + u.koff;
            for (int k0 = 0; k0 < u.nt * 64; k0 += 32) {
                { float f[8]; unpack8(*(const v4u*)(ap + k0), f);
#pragma unroll
                  for (int j = 0; j < 8; ++j) As[(ak + j) * 132 + ar] = f[j]; }
                { float f[8]; unpack8(*(const v4u*)(bp + k0), f);
#pragma unroll
                  for (int j = 0; j < 8; ++j) Bs[(bk + j) * 260 + bn] = f[j];
                  unpack8(*(const v4u*)(bp + k0 + 8), f);
#pragma unroll
                  for (int j = 0; j < 8; ++j) Bs[(bk + 8 + j) * 260 + bn] = f[j]; }
                __syncthreads();
#pragma unroll 4
                for (int k = 0; k < 32; ++k) {
                    const f32x4 a = *(const f32x4*)(As + k * 132 + ty * 4);
                    const f32x4 p0 = *(const f32x4*)(Bs + k * 260 + tx * 8), p1 = *(const f32x4*)(Bs + k * 260 + tx * 8 + 4);
                    const f32x4 q0 = *(const f32x4*)(Bs + k * 260 + 128 + tx * 8), q1 = *(const f32x4*)(Bs + k * 260 + 128 + tx * 8 + 4);
                    const float av[4] = {a.x, a.y, a.z, a.w};
                    const float b0[8] = {p0.x, p0.y, p0.z, p0.w, p1.x, p1.y, p1.z, p1.w};
                    const float b1[8] = {q0.x, q0.y, q0.z, q0.w, q1.x, q1.y, q1.z, q1.w};
#pragma unroll
                    for (int r = 0; r < 4; ++r)
#pragma unroll
                        for (int j = 0; j < 8; ++j) { acc0[r][j] += av[r] * b0[j]; acc1[r][j] += av[r] * b1[j]; }
                }
                __syncthreads();
            }
#pragma unroll
            for (int r = 0; r < 4; ++r) E.elem8(rbase + ty * 4 + r, u.pn, tx * 8, acc0[r], acc1[r], u.atomic);
        }
    }
}

namespace pg8 {
typedef short bf16x8 __attribute__((ext_vector_type(8)));
constexpr int BK = 64, HTB = 128 * BK * 2;
DI int lds_byte(int r, int c) { const int st = (r >> 4) * 2 + (c >> 5), rr = r & 15, cc = c & 31, ob = rr * 64 + cc * 2; return st * 1024 + (ob ^ (((ob >> 9) & 1) << 5)); }
DI void stage_rc(int b, int& R, int& C) { const int st = b / 1024, sb = b % 1024, swz = sb ^ (((sb >> 9) & 1) << 5); R = (st >> 1) * 16 + swz / 64; C = (st & 1) * 32 + (swz % 64) / 2; }
DI int perm32(int rho) { const int n = rho >> 4, i = rho & 15; return 8 * (i >> 2) + 4 * n + (i & 3); }

typedef short s16x16 __attribute__((ext_vector_type(16))); typedef int i32x8 __attribute__((ext_vector_type(8)));
template <bool GATHER, bool F8, class Epi, class Sched>
DI void gemm_phase(LAS unsigned char* lds, const GemmP g, const Sched& S, const Epi& E) {
    int tid_ = threadIdx.x; asm volatile("" : "+v"(tid_));
    const int tid = tid_, wid = __builtin_amdgcn_readfirstlane(tid >> 6), lane = tid & 63, wr = wid >> 2, wc = wid & 3, fr = lane & 15, fq = lane >> 4;
    int R0, C0; stage_rc(tid * 16, R0, C0);
    const unsigned voffB0 = (unsigned)(((R0 & ~31) + perm32(R0 & 31)) * g.ldb + C0) * 2u;
    const unsigned voffA0 = (unsigned)(R0 * g.lda + C0) * 2u;
    const size_t kstep = (size_t)(BK * 2);
    const size_t hstepB = (size_t)128 * g.ldb * 2, pstepB = (size_t)64 * g.ldb * 2;
    const size_t hstepA = (size_t)128 * g.lda * 2, pstepA = (size_t)64 * g.lda * 2;
    const unsigned ldsw = (unsigned)wid * 1024u;
    const int aoff = lds_byte(wr * 64 + fr, fq * 8), boff = lds_byte(wc * 32 + fr, fq * 8);
    LAS unsigned* gtab = (LAS unsigned*)(lds + GTAB_OFF);
    if constexpr (GATHER) {
        Unit u;
#pragma nounroll
        for (int i = 0; i < GTAB_SLOTS && S.next(i, u); ++i)
            if (tid < 256) { int r = g.arow[u.pm * 256 + tid]; if (r < 0) r = 0; gtab[i * 256 + tid] = (unsigned)r * (unsigned)(g.lda * 2); }
        asm volatile("s_waitcnt vmcnt(0) lgkmcnt(0)" ::: "memory"); __builtin_amdgcn_s_barrier(); asm volatile("" ::: "memory");
    }
#define PG8_SA(b, h) (((b) * 2 + (h)) * HTB)
#define PG8_SB(b, h) ((4 + (b) * 2 + (h)) * HTB)
#define PG8_GLDS(gp, bufoff, i) __builtin_amdgcn_global_load_lds((const unsigned*)(gp), (LAS unsigned*)(lds + (bufoff) + ldsw + (i) * 8192), 16, 0, 0)
#define PG8_STAGE_B(bufoff, gbase) do { PG8_GLDS((const char*)(gbase) + voffB0, bufoff, 0); PG8_GLDS((const char*)(gbase) + pstepB + voffB0, bufoff, 1); } while (0)
#define PG8_STAGE_A(bufoff, ubase, kbase, h, ao) do { if constexpr (GATHER) { PG8_GLDS((const char*)(kbase) + (ao)[h][0], bufoff, 0); PG8_GLDS((const char*)(kbase) + (ao)[h][1], bufoff, 1); } \
        else { PG8_GLDS((const char*)(ubase) + (h) * hstepA + voffA0, bufoff, 0); PG8_GLDS((const char*)(ubase) + (h) * hstepA + pstepA + voffA0, bufoff, 1); } } while (0)
#define PG8_LDA(dst, b, h) do { _Pragma("unroll") for (int m = 0; m < 4; ++m) _Pragma("unroll") for (int k = 0; k < 2; ++k) dst[m][k] = *(const LAS bf16x8*)(lds + PG8_SA(b, h) + aoff + m * 2048 + k * 1024); } while (0)
#define PG8_LDB(dst, b, h) do { _Pragma("unroll") for (int n = 0; n < 2; ++n) _Pragma("unroll") for (int k = 0; k < 2; ++k) dst[n][k] = *(const LAS bf16x8*)(lds + PG8_SB(b, h) + boff + n * 2048 + k * 1024); } while (0)
#define PG8_CAT(x) __builtin_bit_cast(i32x8, __builtin_shufflevector((x)[0], (x)[1], 0, 1, 2, 3, 4, 5, 6, 7, 8, 9, 10, 11, 12, 13, 14, 15))
#define PG8_MMA(ai, bj, At, Bt) do { __builtin_amdgcn_s_setprio(1); _Pragma("unroll") for (int m = 0; m < 4; ++m) _Pragma("unroll") for (int n = 0; n < 2; ++n) { \
        if constexpr (F8) acc[ai][bj][m][n] = __builtin_amdgcn_mfma_scale_f32_16x16x128_f8f6f4(PG8_CAT(Bt[n]), PG8_CAT(At[m]), acc[ai][bj][m][n], 0, 0, 0, 0, 0, 0); \
        else { _Pragma("unroll") for (int k = 0; k < 2; ++k) acc[ai][bj][m][n] = __builtin_amdgcn_mfma_f32_16x16x32_bf16(Bt[n][k], At[m][k], acc[ai][bj][m][n], 0, 0, 0); } } __builtin_amdgcn_s_setprio(0); } while (0)
#define PG8_WAIT_V(n) asm volatile("s_waitcnt vmcnt(" #n ")" ::: "memory")
#define PG8_WAIT_L(n) asm volatile("s_waitcnt lgkmcnt(" #n ")" ::: "memory")
#define PG8_BAR __builtin_amdgcn_s_barrier()
#define PG8_SCHED __builtin_amdgcn_sched_barrier(0)
#define PG8_GOFFS(dst, slot, ko) do { _Pragma("unroll") for (int _h = 0; _h < 2; ++_h) _Pragma("unroll") for (int _i = 0; _i < 2; ++_i) \
        dst[_h][_i] = gtab[(slot) * 256 + _h * 128 + _i * 64 + R0] + (unsigned)(C0 * 2) + (unsigned)((ko) * 2); } while (0)
    Unit cur, nxt; int ui = 0;
    if (!S.next(0, cur)) return;
    f32x4 acc[2][2][4][2];
#pragma unroll
    for (int a = 0; a < 2; ++a)
#pragma unroll
        for (int b = 0; b < 2; ++b)
#pragma unroll
            for (int m = 0; m < 4; ++m)
#pragma unroll
                for (int n = 0; n < 2; ++n) acc[a][b][m][n] = (f32x4){0.f, 0.f, 0.f, 0.f};
    bf16x8 At[4][2], B0[2][2], B1[2][2];
    unsigned aoC[2][2] = {{0u, 0u}, {0u, 0u}};
    if constexpr (GATHER) { PG8_GOFFS(aoC, 0, cur.koff); }
    const char* Ab = (const char*)g.A;
    const char* cA = (const char*)g.A + ((size_t)cur.pm * 256 * g.lda + cur.koff) * 2;
    const char* cB = (const char*)cur.Bt + ((size_t)cur.pn * 256 * g.ldb + cur.koff) * 2;
    PG8_STAGE_B(PG8_SB(0, 0), cB); PG8_STAGE_B(PG8_SB(0, 1), cB + hstepB); PG8_STAGE_A(PG8_SA(0, 0), cA, Ab, 0, aoC); PG8_STAGE_A(PG8_SA(0, 1), cA, Ab, 1, aoC);
    if (wr == 1) PG8_BAR;
    PG8_WAIT_V(2); PG8_BAR;
    PG8_STAGE_B(PG8_SB(1, 0), cB + kstep); PG8_STAGE_A(PG8_SA(1, 0), cA + kstep, Ab + kstep, 0, aoC); PG8_STAGE_B(PG8_SB(1, 1), cB + hstepB + kstep);
    PG8_WAIT_V(6); PG8_BAR;
    for (;;) {
        const bool has_next = S.next(ui + 1, nxt);
        const char* nA = has_next ? (const char*)g.A + ((size_t)nxt.pm * 256 * g.lda + nxt.koff) * 2 : cA;
        const char* nB = has_next ? (const char*)nxt.Bt + ((size_t)nxt.pn * 256 * g.ldb + nxt.koff) * 2 : cB;
        const int nt = cur.nt;
        for (int t = 0; t < nt; t += 2) {
            const bool last = (t == nt - 2);
            const char* a1 = cA + (size_t)(t + 1) * kstep; const char* g1 = Ab + (size_t)(t + 1) * kstep;
            const char* a2 = last ? nA : cA + (size_t)(t + 2) * kstep; const char* g2 = last ? Ab : Ab + (size_t)(t + 2) * kstep;
            const char* b2 = last ? nB : cB + (size_t)(t + 2) * kstep;
            const char* a3 = a2 + kstep; const char* g3 = g2 + kstep; const char* b3 = b2 + kstep;
            asm volatile("" : "+s"(a1), "+s"(a2), "+s"(a3), "+s"(b2), "+s"(b3));
            PG8_LDB(B0, 0, 0); PG8_LDB(B1, 0, 1); PG8_SCHED; PG8_LDA(At, 0, 0); PG8_STAGE_A(PG8_SA(1, 1), a1, g1, 1, aoC);
            if constexpr (GATHER) { if (last && has_next) { PG8_GOFFS(aoC, ui + 1, nxt.koff); } }
            PG8_WAIT_V(8); PG8_WAIT_L(0); PG8_BAR; PG8_MMA(0, 0, At, B0); PG8_MMA(0, 1, At, B1); PG8_BAR; PG8_SCHED;
            PG8_LDA(At, 0, 1); PG8_STAGE_B(PG8_SB(0, 0), b2); PG8_STAGE_B(PG8_SB(0, 1), b2 + hstepB); PG8_STAGE_A(PG8_SA(0, 0), a2, g2, 0, aoC);
            PG8_WAIT_V(8); PG8_WAIT_L(0); PG8_BAR; PG8_MMA(1, 0, At, B0); PG8_MMA(1, 1, At, B1); PG8_BAR; PG8_SCHED;
            PG8_LDB(B0, 1, 0); PG8_LDB(B1, 1, 1); PG8_SCHED; PG8_LDA(At, 1, 0); PG8_STAGE_A(PG8_SA(0, 1), a2, g2, 1, aoC);
            PG8_WAIT_V(8); PG8_WAIT_L(0); PG8_BAR; PG8_MMA(0, 0, At, B0); PG8_MMA(0, 1, At, B1); PG8_BAR; PG8_SCHED;
            PG8_LDA(At, 1, 1); PG8_STAGE_B(PG8_SB(1, 0), b3); PG8_STAGE_B(PG8_SB(1, 1), b3 + hstepB); PG8_STAGE_A(PG8_SA(1, 0), a3, g3, 0, aoC);
            PG8_WAIT_V(8); PG8_WAIT_L(0); PG8_BAR; PG8_MMA(1, 0, At, B0); PG8_MMA(1, 1, At, B1); PG8_BAR; PG8_SCHED;
        }
        if (wr == 0) PG8_BAR;
        int te_ = threadIdx.x; asm volatile("" : "+v"(te_));
        const int fr = te_ & 15, fq = (te_ >> 4) & 3;
#pragma unroll
        for (int ai = 0; ai < 2; ++ai)
#pragma unroll
            for (int m = 0; m < 4; ++m) {
                float v0[8], v1[8];
#pragma unroll
                for (int n = 0; n < 2; ++n)
#pragma unroll
                    for (int j = 0; j < 4; ++j) { v0[4 * n + j] = acc[ai][0][m][n][j]; v1[4 * n + j] = acc[ai][1][m][n][j]; }
                E.elem8(cur.pm * 256 + ai * 128 + wr * 64 + m * 16 + fr, cur.pn, wc * 32 + 8 * fq, v0, v1, cur.atomic);
                asm volatile("" ::: "memory");
            }
        if (!has_next) break;
#pragma unroll
        for (int a = 0; a < 2; ++a)
#pragma unroll
            for (int b = 0; b < 2; ++b)
#pragma unroll
                for (int m = 0; m < 4; ++m)
#pragma unroll
                    for (int n = 0; n < 2; ++n) acc[a][b][m][n] = (f32x4){0.f, 0.f, 0.f, 0.f};
        cur = nxt; cA = nA; cB = nB; ++ui;
        if (wr == 1) PG8_BAR;
    }
    PG8_WAIT_V(0);
    PG8_BAR;
#undef PG8_SA
#undef PG8_SB
#undef PG8_GLDS
#undef PG8_STAGE_A
#undef PG8_STAGE_B
#undef PG8_LDA
#undef PG8_LDB
#undef PG8_MMA
#undef PG8_CAT
#undef PG8_WAIT_V
#undef PG8_WAIT_L
#undef PG8_BAR
#undef PG8_SCHED
#undef PG8_GOFFS
}
}
#ifndef NAIVE_GEMM
#define NAIVE_GEMM 0
#endif
template <bool GATHER, bool F8 = false, class Epi, class Sched>
DI void gemm_phase(const Ctx& c, const GemmP g, const Sched& S, const Epi& E) {
#if NAIVE_GEMM
    gemm_phase_naive(c, g, S, E);
#else
    pg8::gemm_phase<GATHER, F8>((LAS unsigned char*)c.lds, g, S, E);
#endif
}

template <class F>
DI void conv_matrix(const Ctx& c, F f, int K, int Ndst, bf16_t* WT) {
    float* scr = (float*)c.wscr;
    const int nblk = Ndst / 32, nitems = (K / 64) * nblk, lane = c.lane;
    for (int item = c.gw; item < nitems; item += c.ngw) {
        const int kb = item / nblk, nb = item % nblk, k0 = 64 * kb, n0 = 32 * nb;
#pragma unroll 8
        for (int i = 0; i < 32; ++i) { const int kk = 2 * i + (lane >> 5); scr[kk * 33 + (lane & 31)] = f(n0 + (lane & 31), k0 + kk); }
        asm volatile("s_waitcnt lgkmcnt(0)" ::: "memory");
        const int cc = lane & 7;
#pragma unroll
        for (int j = 0; j < 4; ++j) { const int n = (lane >> 3) + 8 * j; const float* s = scr + (8 * cc) * 33 + n;
            v4u o; o.x = pk2(s[0 * 33], s[1 * 33]); o.y = pk2(s[2 * 33], s[3 * 33]); o.z = pk2(s[4 * 33], s[5 * 33]); o.w = pk2(s[6 * 33], s[7 * 33]);
            *(v4u*)(WT + (size_t)(n0 + n) * K + k0 + 8 * cc) = o; }
        asm volatile("s_waitcnt lgkmcnt(0)" ::: "memory");
    }
}
template <class F>
DI void conv_matrix8(const Ctx& c, F f, int K, int Ndst, unsigned char* WT, float scale) {
    float* scr = (float*)c.wscr;
    const int nblk = Ndst / 32, nitems = (K / 64) * nblk, lane = c.lane;
    for (int item = c.gw; item < nitems; item += c.ngw) {
        const int kb = item / nblk, nb = item % nblk, k0 = 64 * kb, n0 = 32 * nb;
#pragma unroll 8
        for (int i = 0; i < 32; ++i) { const int kk = 2 * i + (lane >> 5); scr[kk * 33 + (lane & 31)] = f(n0 + (lane & 31), k0 + kk) * scale; }
        asm volatile("s_waitcnt lgkmcnt(0)" ::: "memory");
        const int cc = lane & 7;
#pragma unroll
        for (int j = 0; j < 4; ++j) { const int n = (lane >> 3) + 8 * j; const float* s = scr + (8 * cc) * 33 + n;
            v2u o; o.x = pk4f8(s[0 * 33], s[1 * 33], s[2 * 33], s[3 * 33]); o.y = pk4f8(s[4 * 33], s[5 * 33], s[6 * 33], s[7 * 33]);
            *(v2u*)(WT + (size_t)(n0 + n) * K + k0 + 8 * cc) = o; }
        asm volatile("s_waitcnt lgkmcnt(0)" ::: "memory");
    }
}
struct SrcPlain { const float* W; int N; DI float operator()(int n, int k) const { return W[(size_t)k * N + n]; } };
struct SrcMix {
    const float* W;
    DI float operator()(int n, int k) const {
        int col;
        if (n < 256) col = 384 + n;
        else if (n < 640) col = n - 256;
        else if (n < 672) col = 640 + (n - 640);
        else if (n < 704) col = 2464 + (n - 672);
        else if (n < 712) col = 2496 + (n - 704);
        else if (n < 768) col = -1;
        else if (n < 1792) {
            const int m = n - 768, isk = m >= 512, mm = m & 511, tq = mm >> 8, cc = mm & 255, bj = cc >> 7, wc = (cc >> 5) & 3, i = cc & 31;
            col = (isk ? 1184 : 672) + (tq * 4 + wc) * 64 + 32 * bj + i; }
        else if (n < 2304) col = 1696 + (n - 1792);
        else col = 2208 + (n - 2304);
        return col < 0 ? 0.f : W[(size_t)k * MIXIN + col];
    }
};
struct SrcPlainG { const float* W; int N; const float* g; DI float operator()(int n, int k) const { return W[(size_t)k * N + n] * g[k]; } };
struct SrcGlu { const float* W1; const float* W3; DI float operator()(int n, int k) const { const int t = n >> 8, j = n & 255;
    const uintptr_t d = (uintptr_t)W3 - (uintptr_t)W1; const float* W = (const float*)((uintptr_t)W1 + (j < 128 ? (uintptr_t)0 : d)); return W[(size_t)k * DFF + t * 128 + (j & 127)]; } };

template <bool F8>
DI void conv_tile(const Ctx& c, const float* src0, int ld, void* WT, int K, int n0, int k0, float scale) {
    constexpr int KT = F8 ? 128 : 64, NL = KT / 8;
    LAS float* scr = (LAS float*)((LAS unsigned char*)c.lds + c.wave * WSCR);
    const int lane = c.lane;
    const float* src = src0 + (size_t)(lane >> 3) * ld + (lane & 7) * 4;
    f32x4 v[NL];
#pragma unroll
    for (int i = 0; i < NL; ++i) v[i] = *(const f32x4*)(src + (size_t)(8 * i) * ld);
#pragma unroll
    for (int i = 0; i < NL; ++i) { LAS float* q = scr + (8 * i + (lane >> 3)) * 33 + (lane & 7) * 4; q[0] = v[i].x * scale; q[1] = v[i].y * scale; q[2] = v[i].z * scale; q[3] = v[i].w * scale; }
    const int n = lane & 31, kc = lane >> 5;
#pragma unroll
    for (int j = 0; j < 4; ++j) {
        if constexpr (F8) { const int k = 64 * kc + 16 * j; const LAS float* q = scr + k * 33 + n; v4u o;
            o.x = pk4f8(q[0], q[33], q[66], q[99]); o.y = pk4f8(q[4 * 33], q[5 * 33], q[6 * 33], q[7 * 33]); o.z = pk4f8(q[8 * 33], q[9 * 33], q[10 * 33], q[11 * 33]); o.w = pk4f8(q[12 * 33], q[13 * 33], q[14 * 33], q[15 * 33]);
            *(v4u*)((unsigned char*)WT + (size_t)(n0 + n) * K + k0 + k) = o; }
        else { const int k = 32 * kc + 8 * j; const LAS float* q = scr + k * 33 + n; v4u o;
            o.x = pk2(q[0], q[33]); o.y = pk2(q[2 * 33], q[3 * 33]); o.z = pk2(q[4 * 33], q[5 * 33]); o.w = pk2(q[6 * 33], q[7 * 33]);
            *(v4u*)((bf16_t*)WT + (size_t)(n0 + n) * K + k0 + k) = o; }
    }
}
template <bool F8, class P>
DI void conv_fast(const Ctx& c, P p, int K, int Ndst, void* WT, float scale, int& rot) {
    constexpr int KT = F8 ? 128 : 64;
    const int nblk = Ndst / 32, nitems = (K / KT) * nblk;
    int first = (c.gw - rot) % c.ngw; if (first < 0) first += c.ngw;
    rot = (rot + nitems) % c.ngw;
    for (int item = first; item < nitems; item += c.ngw) {
        const int kb = item / nblk, nb = item % nblk, k0 = KT * kb, n0 = 32 * nb;
        conv_tile<F8>(c, p.row(n0, k0), p.ld, WT, K, n0, k0, scale);
    }
}
struct RowPlain { const float* W; int ld; DI const float* row(int n0, int k0) const { return W + (size_t)k0 * ld + n0; } };
struct RowGlu { const float* W1; const float* W3; int ld; DI const float* row(int n0, int k0) const { const int t = n0 >> 8, j = n0 & 255;
    const uintptr_t d = (uintptr_t)W3 - (uintptr_t)W1; const float* W = (const float*)((uintptr_t)W1 + (j < 128 ? (uintptr_t)0 : d)); return W + (size_t)k0 * ld + t * 128 + (j & 127); } };

constexpr int MOE_IT13 = (D / 128) * (2 * DFF / 32), MOE_IT2 = (DFF / 128) * (D / 32);
template <int KIND>
DI void moe_conv_items(const Ctx& c, const float* const* in, unsigned char* ws, int lo, int hi, int w, int nw) {
    for (int g = lo + w; g < hi; g += nw) {
        if constexpr (KIND == 0) { const int e = g / MOE_IT13, item = g % MOE_IT13, nblk = 2 * DFF / 32, kb = item / nblk, nb = item % nblk, k0 = 128 * kb, n0 = 32 * nb;
            const RowGlu p{in[24] + (size_t)e * D * DFF, in[25] + (size_t)e * D * DFF, DFF};
            conv_tile<true>(c, p.row(n0, k0), DFF, ws + WS_MW13 + (size_t)e * 2 * DFF * D, D, n0, k0, F8_SW1); }
        else { const int e = g / MOE_IT2, item = g % MOE_IT2, nblk = D / 32, kb = item / nblk, nb = item % nblk, k0 = 128 * kb, n0 = 32 * nb;
            conv_tile<true>(c, in[26] + (size_t)e * DFF * D + (size_t)k0 * D + n0, D, ws + WS_MW2 + (size_t)e * D * DFF, DFF, n0, k0, F8_SW2); }
    }
}
DI bool idle_slot(const Ctx& c, int nwg, int& w, int& nw) { const int busy = nwg % c.G; if (busy == 0 || c.bid < busy) return false; w = (c.bid - busy) * 8 + c.wave; nw = (c.G - busy) * 8; return true; }
constexpr int IDLE_PER_WAVE = 3;
DI int idle_items(int G, int nwg, int cap) { const int busy = nwg % G; const int n = busy ? IDLE_PER_WAVE * 8 * (G - busy) : 0; return n < cap ? n : cap; }
constexpr int NWG_MIXIN = MP / 256 * (MIXN / 256), NWG_FFN1 = MP / 256 * (2 * DFF / 256), NWG_WIN = MP / 256 * 12;

DI void rms_row_to_bf16(const f32x4 (&v)[4], const float* g, bf16_t* orow, int lane) {
    float ss = 0.f;
#pragma unroll
    for (int j = 0; j < 4; ++j) ss += (v[j].x * v[j].x + v[j].y * v[j].y) + (v[j].z * v[j].z + v[j].w * v[j].w);
    const float rstd = 1.0f / sqrtf(wave_sum(ss) * (1.f / D) + EPS);
#pragma unroll
    for (int j = 0; j < 4; ++j) { const f32x4 gg = *(const f32x4*)(g + 4 * lane + 256 * j);
        v2u o; o.x = pk2(v[j].x * rstd * gg.x, v[j].y * rstd * gg.y); o.y = pk2(v[j].z * rstd * gg.z, v[j].w * rstd * gg.w);
        *(v2u*)(orow + 4 * lane + 256 * j) = o; }
}
DI void phase_prologue_rows(const Ctx& c, const float* x, const float* meta, const float* g, bf16_t* h, bf16_t* XN) {
    for (int m = c.gw; m < MP; m += c.ngw) {
        const int b = m / LP, t = m % LP;
        const float* src = t < NMETA ? meta + (size_t)t * D : (t < LTOT ? x + ((size_t)b * SEQ + (t - NMETA)) * D : nullptr);
        f32x4 v[4];
#pragma unroll
        for (int j = 0; j < 4; ++j) v[j] = src ? *(const f32x4*)(src + 4 * c.lane + 256 * j) : (f32x4){0.f, 0.f, 0.f, 0.f};
#pragma unroll
        for (int j = 0; j < 4; ++j) { v2u o; o.x = pk2(v[j].x, v[j].y); o.y = pk2(v[j].z, v[j].w); *(v2u*)(h + (size_t)m * D + 4 * c.lane + 256 * j) = o; }
        rms_row_to_bf16(v, g, XN + (size_t)m * D, c.lane);
    }
}
DI void phase_norm_rows(const Ctx& c, bf16_t* h, const float* g, bf16_t* XN, int nrows, const StaticSched& S, const float* part) {
    const int tail = S.nwg - S.full;
    for (int m = c.gw; m < nrows; m += c.ngw) {
        f32x4 v[4];
#pragma unroll
        for (int j = 0; j < 4; ++j) { const v2u w = *(const v2u*)(h + (size_t)m * D + 4 * c.lane + 256 * j); v[j] = (f32x4){lo2f(w.x), hi2f(w.x), lo2f(w.y), hi2f(w.y)}; }
        if (tail > 0) {
            bool any = false;
#pragma unroll
            for (int j = 0; j < 4; ++j) { const int L = S.index_of(m >> 8, j);
                if (L >= S.full) { any = true; const float* p = part + ((size_t)(L - S.full) * S.S * 256 + (m & 255)) * 256 + 4 * c.lane;
                    for (int kc = 0; kc < S.S; ++kc) v[j] += *(const f32x4*)(p + (size_t)kc * 65536);
                    v2u o; o.x = pk2(v[j].x, v[j].y); o.y = pk2(v[j].z, v[j].w); *(v2u*)(h + (size_t)m * D + 4 * c.lane + 256 * j) = o;
                    v[j] = (f32x4){lo2f(o.x), hi2f(o.x), lo2f(o.y), hi2f(o.y)}; } }
            (void)any;
        }
        rms_row_to_bf16(v, g, XN + (size_t)m * D, c.lane);
    }
}
template <int NN, int SLOT>
DI void phase_moe_fix(const Ctx& c, const MoeSched<NN>& S, const int* rowtok, const float* rowgate, const float* part, float* out, float sc, bf16_t* parta, const bf16_t* h3) {
    const int tail = S.nM * NN - S.full;
    int lane_ = c.lane; asm volatile("" : "+v"(lane_));
    for (int it = c.gw; it < tail * 256; it += c.ngw) {
        const int ti = it >> 8, r = it & 255, id = S.full + ti, pm = id / NN, pn = id % NN;
        const int tok = rowtok[pm * 256 + r]; if (tok < 0) continue;
        const float gt = rowgate[pm * 256 + r] * sc;
        const float* p = part + ((size_t)ti * S.S * 256 + r) * 256 + 4 * lane_;
        f32x4 a = (f32x4){0.f, 0.f, 0.f, 0.f};
        for (int kc = 0; kc < S.S; ++kc) a += *(const f32x4*)(p + (size_t)kc * 65536);
        a = a * gt;
        const size_t e = (size_t)tok * D + pn * 256 + 4 * lane_;
        if constexpr (SLOT == 0) { v2u o; o.x = pk2(a.x, a.y); o.y = pk2(a.z, a.w); *(v2u*)(parta + e) = o; }
        else { const v2u pa = *(const v2u*)(parta + e), hh = *(const v2u*)(h3 + e);
            a += (f32x4){lo2f(pa.x) + lo2f(hh.x), hi2f(pa.x) + hi2f(hh.x), lo2f(pa.y) + lo2f(hh.y), hi2f(pa.y) + hi2f(hh.y)};
            *(f32x4*)(out + e) = a; }
    }
}
DI void transpose_v(const Ctx& c, const bf16_t* src, int pitch, int col0, int hstride, bf16_t* VT) {
    bf16_t* scr = (bf16_t*)c.wscr;
    const int lane = c.lane, nitems = NB * (LP / 64) * 8;
    for (int it = c.gw; it < nitems; it += c.ngw) {
        const int h = it & 7, tt = (it >> 3) % (LP / 64), b = (it >> 3) / (LP / 64), t0 = tt * 64;
        const bf16_t* sp = src + ((size_t)b * LP + t0) * pitch + col0 + h * hstride;
#pragma unroll
        for (int i = 0; i < 8; ++i) { const int r = i * 8 + (lane >> 3), ch = lane & 7; const v4u w = *(const v4u*)(sp + (size_t)r * pitch + ch * 8);
            unsigned* d = (unsigned*)(scr + r * 66 + ch * 8); d[0] = w.x; d[1] = w.y; d[2] = w.z; d[3] = w.w; }
        asm volatile("s_waitcnt lgkmcnt(0)" ::: "memory");
        bf16_t* dp = VT + ((size_t)(b * 8 + h) * 64) * LP + t0;
#pragma unroll
        for (int i = 0; i < 8; ++i) { const int d = i * 8 + (lane >> 3), ch = lane & 7;
            const bf16_t* s = scr + ((ch >> 1) * 16 + (ch & 1) * 4) * 66 + d;
            v4u o; o.x = (unsigned)s[0] | ((unsigned)s[66] << 16); o.y = (unsigned)s[2 * 66] | ((unsigned)s[3 * 66] << 16);
            o.z = (unsigned)s[8 * 66] | ((unsigned)s[9 * 66] << 16); o.w = (unsigned)s[10 * 66] | ((unsigned)s[11 * 66] << 16);
            *(v4u*)(dp + (size_t)d * LP + ch * 8) = o; }
        asm volatile("s_waitcnt lgkmcnt(0)" ::: "memory");
    }
}
DI void phase_ew2(const Ctx& c, bf16_t* LAT, bf16_t* DQ, bf16_t* DK, bf16_t* KR, bf16_t* IK, float* IW,
                  const float* g_q_lat, const float* g_kv_lat, const float* g_dq, const float* g_dk) {
    const int lane = c.lane;
    for (int m = c.gw; m < MP; m += c.ngw) {
        bf16_t* L = LAT + (size_t)m * 768;
        {
            const v2u w = *(const v2u*)(L + 4 * lane);
            const float a = lo2f(w.x), b = hi2f(w.x), cc = lo2f(w.y), d = hi2f(w.y);
            const float rstd = 1.0f / sqrtf(wave_sum(a * a + b * b + cc * cc + d * d) * (1.f / KVR) + EPS);
            const f32x4 g = *(const f32x4*)(g_kv_lat + 4 * lane);
            v2u o; o.x = pk2(a * rstd * g.x, b * rstd * g.y); o.y = pk2(cc * rstd * g.z, d * rstd * g.w);
            *(v2u*)(L + 4 * lane) = o;
        }
        {
            unsigned* p = (unsigned*)(L + 256 + 6 * lane);
            const unsigned w0 = p[0], w1 = p[1], w2 = p[2];
            float v[6] = {lo2f(w0), hi2f(w0), lo2f(w1), hi2f(w1), lo2f(w2), hi2f(w2)};
            float ss = 0.f;
#pragma unroll
            for (int i = 0; i < 6; ++i) ss += v[i] * v[i];
            const float rstd = 1.0f / sqrtf(wave_sum(ss) * (1.f / QR) + EPS);
#pragma unroll
            for (int i = 0; i < 6; ++i) v[i] = v[i] * rstd * g_q_lat[6 * lane + i];
            p[0] = pk2(v[0], v[1]); p[1] = pk2(v[2], v[3]); p[2] = pk2(v[4], v[5]);
        }
        {
            const unsigned* L32 = (const unsigned*)L;
            if (lane < 16) ((unsigned*)KR)[(size_t)m * 16 + lane] = L32[320 + lane];
            else if (lane < 32) ((unsigned*)IK)[(size_t)m * 16 + (lane - 16)] = L32[336 + (lane - 16)];
            else if (lane < 40) IW[(size_t)m * 8 + (lane - 32)] = bf2f(L[704 + (lane - 32)]);
        }
#pragma unroll
        for (int which = 0; which < 2; ++which) {
            bf16_t* p = (which == 0 ? DQ : DK) + (size_t)m * 512 + 8 * lane;
            const float* g = (which == 0 ? g_dq : g_dk) + 8 * (lane & 7);
            float v[8]; unpack8(*(const v4u*)p, v);
            float ss = 0.f;
#pragma unroll
            for (int i = 0; i < 8; ++i) ss += v[i] * v[i];
            ss += __shfl_xor(ss, 1); ss += __shfl_xor(ss, 2); ss += __shfl_xor(ss, 4);
            const float rstd = 1.0f / sqrtf(ss * (1.f / 64.f) + EPS) * (which == 0 ? DSA_QS : 1.f);
#pragma unroll
            for (int i = 0; i < 8; ++i) v[i] = v[i] * rstd * g[i];
            *(v4u*)p = pack8(v);
        }
    }
}
__device__ const double ROPE_INV[16] = {1.0, 0.5623413251903491, 0.31622776601683794, 0.1778279410038923, 0.1, 0.05623413251903491, 0.03162277660168379, 0.01778279410038923,
    0.01, 0.005623413251903491, 0.0031622776601683794, 0.0017782794100389228, 0.001, 0.0005623413251903491, 0.00031622776601683794, 0.00017782794100389227};
DI void rope_cs(int t, int i, float& cs, float& sn) {
    const float inv = (float)ROPE_INV[i]; const float ang = (float)t * inv;
    double rev = (double)ang * 0.15915494309189535; rev -= __builtin_rint(rev);
    const float fr = (float)rev; cs = __builtin_amdgcn_cosf(fr); sn = __builtin_amdgcn_sinf(fr);
}
DI void phase_ew4(const Ctx& c, bf16_t* Qm, const bf16_t* KV, const bf16_t* KR, bf16_t* Km, const float* g_qn, const float* g_kn) {
    float* scr = (float*)c.wscr; const int lane = c.lane;
    for (int m = c.gw; m < MP; m += c.ngw) {
        const int t = m % LP;
        float cs[2], sn[2];
#pragma unroll
        for (int e = 0; e < 2; ++e) rope_cs(t, (lane * 2 + e) & 15, cs[e], sn[e]);
        {
            unsigned* p = (unsigned*)(Qm + (size_t)m * MLAW + 12 * lane);
            float v[12];
#pragma unroll
            for (int i = 0; i < 6; ++i) { const unsigned w = p[i]; v[2 * i] = lo2f(w); v[2 * i + 1] = hi2f(w); }
            float ss = 0.f;
#pragma unroll
            for (int i = 0; i < 12; ++i) ss += v[i] * v[i];
            ss += __shfl_xor(ss, 1); ss += __shfl_xor(ss, 2); ss += __shfl_xor(ss, 4);
            const float rstd = 1.0f / sqrtf(ss * (1.f / MQK) + EPS);
#pragma unroll
            for (int i = 0; i < 12; ++i) scr[12 * lane + i] = v[i] * rstd * g_qn[12 * (lane & 7) + i];
            asm volatile("s_waitcnt lgkmcnt(0)" ::: "memory");
#pragma unroll
            for (int e = 0; e < 2; ++e) { const int pr = lane * 2 + e, hh = pr >> 4, i = pr & 15; float* q = scr + hh * 96 + 64;
                const float x1 = q[i], x2 = q[16 + i]; q[i] = x1 * cs[e] - x2 * sn[e]; q[16 + i] = x1 * sn[e] + x2 * cs[e]; }
            asm volatile("s_waitcnt lgkmcnt(0)" ::: "memory");
#pragma unroll
            for (int i = 0; i < 6; ++i) p[i] = pk2(scr[12 * lane + 2 * i] * MLA_QS, scr[12 * lane + 2 * i + 1] * MLA_QS);
            asm volatile("s_waitcnt lgkmcnt(0)" ::: "memory");
        }
        {
            const int hh = lane >> 3, sub = lane & 7;
            float kn[8]; unpack8(*(const v4u*)(KV + (size_t)m * 1024 + hh * 128 + 8 * sub), kn);
            const v2u rw = *(const v2u*)(KR + (size_t)m * 768 + 640 + 4 * sub);
            float kr[4] = {lo2f(rw.x), hi2f(rw.x), lo2f(rw.y), hi2f(rw.y)};
            float ss = 0.f;
#pragma unroll
            for (int i = 0; i < 8; ++i) ss += kn[i] * kn[i];
#pragma unroll
            for (int i = 0; i < 4; ++i) ss += kr[i] * kr[i];
            ss += __shfl_xor(ss, 1); ss += __shfl_xor(ss, 2); ss += __shfl_xor(ss, 4);
            const float rstd = 1.0f / sqrtf(ss * (1.f / MQK) + EPS);
#pragma unroll
            for (int i = 0; i < 8; ++i) scr[hh * 96 + 8 * sub + i] = kn[i] * rstd * g_kn[8 * sub + i];
#pragma unroll
            for (int i = 0; i < 4; ++i) scr[hh * 96 + 64 + 4 * sub + i] = kr[i] * rstd * g_kn[64 + 4 * sub + i];
            asm volatile("s_waitcnt lgkmcnt(0)" ::: "memory");
#pragma unroll
            for (int e = 0; e < 2; ++e) { const int pr = lane * 2 + e, h2 = pr >> 4, i = pr & 15; float* q = scr + h2 * 96 + 64;
                const float x1 = q[i], x2 = q[16 + i]; q[i] = x1 * cs[e] - x2 * sn[e]; q[16 + i] = x1 * sn[e] + x2 * cs[e]; }
            asm volatile("s_waitcnt lgkmcnt(0)" ::: "memory");
            unsigned* p = (unsigned*)(Km + (size_t)m * MLAW + 12 * lane);
#pragma unroll
            for (int i = 0; i < 6; ++i) p[i] = pk2(scr[12 * lane + 2 * i], scr[12 * lane + 2 * i + 1]);
            asm volatile("s_waitcnt lgkmcnt(0)" ::: "memory");
        }
    }
}
DI void phase_conv(const Ctx& c, const bf16_t* Z2, const float* cw, bf16_t* YC) {
    const int lane = c.lane;
    for (int r = c.gw; r < MR; r += c.ngw) {
        const int b = r >> 12, tt = r & 4095; const size_t m = (size_t)b * LP + NMETA + tt;
#pragma unroll
        for (int j = 0; j < 4; ++j) { const int col = 4 * lane + 256 * j;
            f32x4 y = (f32x4){0.f, 0.f, 0.f, 0.f};
#pragma unroll
            for (int k = 0; k < 3; ++k) { const v2u zz = *(const v2u*)(Z2 + (m - 2 + k) * 2048 + col); const f32x4 w = *(const f32x4*)(cw + k * 1024 + col);
                y.x += w.x * lo2f(zz.x); y.y += w.y * hi2f(zz.x); y.z += w.z * lo2f(zz.y); y.w += w.w * hi2f(zz.y); }
            const v2u bg = *(const v2u*)(Z2 + m * 2048 + 1024 + col);
            v2u o; o.x = pk2(lo2f(bg.x) * y.x, hi2f(bg.x) * y.y); o.y = pk2(lo2f(bg.y) * y.z, hi2f(bg.y) * y.w);
            *(v2u*)(YC + (size_t)r * D + col) = o; }
    }
}
DI void phase_route(const Ctx& c, const bf16_t* h, const float* g, const float* wr, unsigned char* XN2, unsigned* cnt, int* asg, float* gate) {
    float* wt = (float*)c.lds;
    LAS unsigned* lcnt = (LAS unsigned*)((LAS unsigned char*)c.lds + 32768);
    LAS unsigned* lrec = lcnt + 32;
    __syncthreads();
    for (int i = c.tid; i < D * NE; i += 512) { const int k = i >> 3, e = i & 7; wt[e * D + k] = wr[i]; }
    if (c.tid < 32) lcnt[c.tid] = 0u;
    __syncthreads();
    const int lane = c.lane; int kk = 0;
    for (int r = c.gw; r < MR; r += c.ngw) {
        f32x4 v[4]; float ss = 0.f;
#pragma unroll
        for (int j = 0; j < 4; ++j) { const v2u w = *(const v2u*)(h + (size_t)r * D + 4 * lane + 256 * j); v[j] = (f32x4){lo2f(w.x), hi2f(w.x), lo2f(w.y), hi2f(w.y)}; ss += (v[j].x * v[j].x + v[j].y * v[j].y) + (v[j].z * v[j].z + v[j].w * v[j].w); }
        const float rstd = 1.0f / sqrtf(wave_sum(ss) * (1.f / D) + EPS);
        float lg[NE];
#pragma unroll
        for (int e = 0; e < NE; ++e) lg[e] = 0.f;
#pragma unroll
        for (int j = 0; j < 4; ++j) { const f32x4 gg = *(const f32x4*)(g + 4 * lane + 256 * j);
            const f32x4 xn = (f32x4){v[j].x * rstd * gg.x, v[j].y * rstd * gg.y, v[j].z * rstd * gg.z, v[j].w * rstd * gg.w};
            *(unsigned*)(XN2 + (size_t)r * D + 4 * lane + 256 * j) = pk4f8(xn.x * F8_SX, xn.y * F8_SX, xn.z * F8_SX, xn.w * F8_SX);
#pragma unroll
            for (int e = 0; e < NE; ++e) { const f32x4 w = *(const f32x4*)(wt + e * D + 4 * lane + 256 * j); lg[e] += (xn.x * w.x + xn.y * w.y) + (xn.z * w.z + xn.w * w.w); } }
#pragma unroll
        for (int e = 0; e < NE; ++e) lg[e] = wave_sum(lg[e]);
        int e0 = 0; float v0 = lg[0];
#pragma unroll
        for (int e = 1; e < NE; ++e) if (lg[e] > v0) { v0 = lg[e]; e0 = e; }
        int e1 = -1; float v1 = -INFINITY;
#pragma unroll
        for (int e = 0; e < NE; ++e) if (e != e0 && lg[e] > v1) { v1 = lg[e]; e1 = e; }
        const float ex = __expf(v1 - v0); const float g0 = 1.f / (1.f + ex), g1 = ex / (1.f + ex);
        if (lane == 0) {
            const unsigned p0 = __hip_atomic_fetch_add(lcnt + e0, 1u, __ATOMIC_RELAXED, __HIP_MEMORY_SCOPE_WORKGROUP), p1 = __hip_atomic_fetch_add(lcnt + 8 + e1, 1u, __ATOMIC_RELAXED, __HIP_MEMORY_SCOPE_WORKGROUP);
            lrec[(c.wave * 32 + kk) * 2] = (unsigned)e0 | (p0 << 4); lrec[(c.wave * 32 + kk) * 2 + 1] = (unsigned)e1 | (p1 << 4); gate[r] = g0; gate[MR + r] = g1;
        }
        ++kk;
    }
    __syncthreads();
    if (c.tid < 16) lcnt[16 + c.tid] = __hip_atomic_fetch_add(cnt + c.tid, lcnt[c.tid], RLX_AGENT);
    __syncthreads();
    if (lane == 0) { kk = 0;
        for (int r = c.gw; r < MR; r += c.ngw, ++kk) { const unsigned a0 = lrec[(c.wave * 32 + kk) * 2], a1 = lrec[(c.wave * 32 + kk) * 2 + 1];
            asg[r] = (int)((a0 & 15u) | (((a0 >> 4) + lcnt[16 + (a0 & 15u)]) << 4)); asg[MR + r] = (int)((a1 & 15u) | (((a1 >> 4) + lcnt[16 + 8 + (a1 & 15u)]) << 4)); } }
}
DI void phase_scatter(const Ctx& c, const unsigned* cnt, const int* asg, const float* gate, int* rowtok, float* rowgate) {
    int base[2][NE];
#pragma unroll
    for (int s = 0; s < 2; ++s) { int acc = 0;
#pragma unroll
        for (int e = 0; e < NE; ++e) { base[s][e] = acc; acc += (int)((cnt[s * 8 + e] + 255u) & ~255u); } }
    const int gt = c.bid * 512 + c.tid, ngt = c.G * 512;
    for (int i = gt; i < 2 * MR; i += ngt) {
        const int s = i >= MR ? 1 : 0, r = i - s * MR; const int a = asg[i], e = a & 15, pos = a >> 4;
        int bs = 0;
#pragma unroll
        for (int k = 0; k < NE; ++k) if (k == e) bs = base[s][k];
        rowtok[s * MOE_ROWS + bs + pos] = r; rowgate[s * MOE_ROWS + bs + pos] = gate[i];
    }
}

DI void phase_mla_naive(const Ctx& c, const bf16_t* Qm, const bf16_t* Km, const bf16_t* VmT, bf16_t* O) {
    float* sc = (float*)c.wscr; const int lane = c.lane;
    for (int it = c.gw; it < MP * 8; it += c.ngw) {
        const int m = it >> 3, h = it & 7, b = m / LP, t = m % LP;
        bf16_t* op = O + (size_t)m * D + h * 64 + lane;
        if (t >= LTOT) { *op = 0; continue; }
        float q[96];
        { const bf16_t* qp = Qm + (size_t)m * MLAW + h * 96;
#pragma unroll
          for (int i = 0; i < 12; ++i) { float f[8]; unpack8(*(const v4u*)(qp + 8 * i), f);
#pragma unroll
              for (int j = 0; j < 8; ++j) q[8 * i + j] = f[j]; } }
        const int n = t + 1; float mx = -INFINITY;
        for (int s0 = 0; s0 < n; s0 += 64) { const int s = s0 + lane; float v = -INFINITY;
            if (s < n) { const bf16_t* kp = Km + ((size_t)b * LP + s) * MLAW + h * 96; float d = 0.f;
#pragma unroll
                for (int i = 0; i < 12; ++i) { float f[8]; unpack8(*(const v4u*)(kp + 8 * i), f);
#pragma unroll
                    for (int j = 0; j < 8; ++j) d += q[8 * i + j] * f[j]; }
                v = d; }
            sc[s0 + lane] = v; mx = fmaxf(mx, v); }
        mx = wave_max(mx);
        asm volatile("s_waitcnt lgkmcnt(0)" ::: "memory");
        float l = 0.f, acc = 0.f; const bf16_t* vp = VmT + ((size_t)(b * 8 + h) * 64 + lane) * LP;
        for (int s0 = 0; s0 < ((n + 15) & ~15); s0 += 8) {
            v4u w = *(const v4u*)(vp + s0); float f[8]; unpack8(w, f);
#pragma unroll
            for (int j = 0; j < 8; ++j) { const int pp = (s0 + j) & 15; const int s = ((s0 + j) & ~15) + (pp < 4 ? pp : pp < 8 ? pp + 4 : pp < 12 ? pp - 4 : pp);
                if (s < n) { const float p = exp2f(sc[s] - mx); l += p; acc += p * f[j]; } }
        }
        *op = (bf16_t)f2bf(acc / l);
        asm volatile("s_waitcnt lgkmcnt(0)" ::: "memory");
    }
}
DI unsigned fkey(float f) { const unsigned u = __float_as_uint(f); return (u & 0x80000000u) ? ~u : (u | 0x80000000u); }
DI void phase_dsa_naive(const Ctx& c, const bf16_t* DQ, const bf16_t* DK, const bf16_t* DV, const bf16_t* IQ, const bf16_t* IK, const float* IW, const float* lut, bf16_t* O) {
    unsigned* key = (unsigned*)c.wscr;
    float* qf = (float*)(c.wscr + 16448);
    unsigned short* sel = (unsigned short*)(c.wscr + 17472);
    const int lane = c.lane;
    for (int m = c.gw; m < MP; m += c.ngw) {
        const int b = m / LP, t = m % LP;
        bf16_t* op = O + (size_t)m * D + 512;
        if (t >= LTOT) { for (int i = lane; i < 512; i += 64) op[i] = 0; continue; }
        const int n = t + 1;
        {
            float f[4]; const v2u w = *(const v2u*)(IQ + (size_t)m * 256 + 4 * lane); f[0] = lo2f(w.x); f[1] = hi2f(w.x); f[2] = lo2f(w.y); f[3] = hi2f(w.y);
            *(f32x4*)(qf + 4 * lane) = (f32x4){f[0], f[1], f[2], f[3]};
        }
        float wv[8];
#pragma unroll
        for (int hh = 0; hh < 8; ++hh) wv[hh] = IW[(size_t)m * 8 + hh];
        asm volatile("s_waitcnt lgkmcnt(0)" ::: "memory");
        for (int s0 = 0; s0 < n; s0 += 64) { const int s = s0 + lane;
            if (s < n) { const bf16_t* kp = IK + ((size_t)b * LP + s) * 32; float kk[32];
#pragma unroll
                for (int i = 0; i < 4; ++i) { float f[8]; unpack8(*(const v4u*)(kp + 8 * i), f);
#pragma unroll
                    for (int j = 0; j < 8; ++j) kk[8 * i + j] = f[j]; }
                float score = 0.f;
#pragma unroll
                for (int hh = 0; hh < 8; ++hh) { float d = 0.f;
#pragma unroll
                    for (int i = 0; i < 8; ++i) { const f32x4 qq = *(const f32x4*)(qf + hh * 32 + 4 * i); d += (qq.x * kk[4 * i] + qq.y * kk[4 * i + 1]) + (qq.z * kk[4 * i + 2] + qq.w * kk[4 * i + 3]); }
                    score += wv[hh] * fmaxf(d, 0.f); }
                key[s] = fkey(score); } }
        asm volatile("s_waitcnt lgkmcnt(0)" ::: "memory");
        unsigned T = 0u; int tie = LP;
        if (n > TOPK) {
            for (int bit = 31; bit >= 0; --bit) { const unsigned cand = T | (1u << bit); int cn = 0;
                for (int s0 = 0; s0 < n; s0 += 64) { const int s = s0 + lane; const bool ge = (s < n) && key[s] >= cand; cn += __popcll(__ballot(ge)); }
                if (cn >= TOPK) T = cand; }
            int cg = 0;
            for (int s0 = 0; s0 < n; s0 += 64) { const int s = s0 + lane; cg += __popcll(__ballot((s < n) && key[s] > T)); }
            const int need = TOPK - cg; int run = 0; tie = -1;
            for (int s0 = 0; s0 < n && tie < 0; s0 += 64) { const int s = s0 + lane; unsigned long long mk = __ballot((s < n) && key[s] == T); const int pc = __popcll(mk);
                if (run + pc >= need) { int kth = need - run; while (kth > 1) { mk &= mk - 1; --kth; } tie = s0 + (int)__builtin_ctzll(mk); }
                run += pc; }
        }
        int nsel = 0;
        for (int s0 = 0; s0 < n; s0 += 64) { const int s = s0 + lane; const unsigned k = (s < n) ? key[s] : 0u;
            const bool sl = (s < n) && (k > T || (k == T && s <= tie) || n <= TOPK);
            const unsigned long long mk = __ballot(sl); const int pos = nsel + (int)__popcll(mk & ((1ull << lane) - 1ull));
            if (sl && pos < TOPK) sel[pos] = (unsigned short)s; nsel += __popcll(mk); }
        if (nsel > TOPK) nsel = TOPK;
        asm volatile("s_waitcnt lgkmcnt(0)" ::: "memory");
        float* pl = qf;
        for (int hh = 0; hh < 8; ++hh) {
            float q[64];
            { const bf16_t* qp = DQ + (size_t)m * 512 + hh * 64;
#pragma unroll
              for (int i = 0; i < 8; ++i) { float f[8]; unpack8(*(const v4u*)(qp + 8 * i), f);
#pragma unroll
                  for (int j = 0; j < 8; ++j) q[8 * i + j] = f[j]; } }
            float sv[4]; float mx = -INFINITY;
#pragma unroll
            for (int cc = 0; cc < 4; ++cc) { const int j = cc * 64 + lane; sv[cc] = -INFINITY;
                if (j < nsel) { const int s = sel[j]; const bf16_t* kp = DK + ((size_t)b * LP + s) * 512 + hh * 64; float d = 0.f;
#pragma unroll
                    for (int i = 0; i < 8; ++i) { float f[8]; unpack8(*(const v4u*)(kp + 8 * i), f);
#pragma unroll
                        for (int jj = 0; jj < 8; ++jj) d += q[8 * i + jj] * f[jj]; }
                    int dist = t - s; if (dist > 127) dist = 127;
                    sv[cc] = d + lut[dist * 8 + hh]; }
                mx = fmaxf(mx, sv[cc]); }
            mx = wave_max(mx); float l = 0.f;
#pragma unroll
            for (int cc = 0; cc < 4; ++cc) { const int j = cc * 64 + lane; const float p = (j < nsel) ? exp2f(sv[cc] - mx) : 0.f; pl[j] = p; l += p; }
            l = wave_sum(l);
            asm volatile("s_waitcnt lgkmcnt(0)" ::: "memory");
            float acc = 0.f;
            for (int j = 0; j < nsel; ++j) acc += pl[j] * bf2f(DV[((size_t)b * LP + sel[j]) * 512 + hh * 64 + lane]);
            op[hh * 64 + lane] = (bf16_t)f2bf(acc / l);
            asm volatile("s_waitcnt lgkmcnt(0)" ::: "memory");
        }
    }
}


typedef short bf16x8_t __attribute__((ext_vector_type(8)));
typedef float f32x16 __attribute__((ext_vector_type(16)));
template <int NREG>
DI void select_row(const LAS unsigned* kb, LAS unsigned* hist, int n, int lane, unsigned long long* mrow) {
    unsigned k[NREG];
#pragma unroll
    for (int r = 0; r < NREG; ++r) { const int s = r * 64 + lane; k[r] = (s < n) ? kb[s] : 0u; }
    unsigned P = 0u; int need = TOPK; bool exact = false; unsigned T = 0u; int neq = 0;
#pragma unroll 1
    for (int level = 0; level < 4; ++level) {
        const int shift = 24 - 8 * level;
        if (level > 0) {
            *(LAS v4u*)(hist + 4 * lane) = (v4u){0u, 0u, 0u, 0u};
            asm volatile("s_waitcnt lgkmcnt(0)" ::: "memory");
#pragma unroll
            for (int r = 0; r < NREG; ++r) { const unsigned bin = ((k[r] >> (shift + 8)) == P) ? ((k[r] >> shift) & 255u) : (256u + (unsigned)lane);
                __hip_atomic_fetch_add(hist + bin, 1u, __ATOMIC_RELAXED, __HIP_MEMORY_SCOPE_WORKGROUP); }
            asm volatile("s_waitcnt lgkmcnt(0)" ::: "memory");
        }
        const v4u h = *(const LAS v4u*)(hist + 4 * lane);
        const int h0 = (int)h.x, h1 = (int)h.y, h2 = (int)h.z, h3 = (int)h.w, sl = h0 + h1 + h2 + h3;
        int incl = sl;
        incl += __builtin_amdgcn_update_dpp(0, incl, 0x101, 0xf, 0xf, true);
        incl += __builtin_amdgcn_update_dpp(0, incl, 0x102, 0xf, 0xf, true);
        incl += __builtin_amdgcn_update_dpp(0, incl, 0x104, 0xf, 0xf, true);
        incl += __builtin_amdgcn_update_dpp(0, incl, 0x108, 0xf, 0xf, true);
        { const int t1 = __builtin_amdgcn_readlane(incl, 16), t2 = __builtin_amdgcn_readlane(incl, 32), t3 = __builtin_amdgcn_readlane(incl, 48);
          incl += lane < 16 ? t1 + t2 + t3 : (lane < 32 ? t2 + t3 : (lane < 48 ? t3 : 0)); }
        const int a3 = incl - sl, a2 = a3 + h3, a1 = a2 + h2, a0 = a1 + h1;
        int bsel = -1, asel = 0, hsel = 0;
        if (a3 < need && need <= a3 + h3) { bsel = 3; asel = a3; hsel = h3; }
        if (a2 < need && need <= a2 + h2) { bsel = 2; asel = a2; hsel = h2; }
        if (a1 < need && need <= a1 + h1) { bsel = 1; asel = a1; hsel = h1; }
        if (a0 < need && need <= a0 + h0) { bsel = 0; asel = a0; hsel = h0; }
        const unsigned long long mk = __ballot(bsel >= 0);
        const int src = (int)__builtin_ctzll(mk);
        const int bb = __builtin_amdgcn_readlane(bsel, src), aa = __builtin_amdgcn_readlane(asel, src), hh = __builtin_amdgcn_readlane(hsel, src);
        P = (P << 8) | (unsigned)(4 * src + bb); need -= aa; neq = hh;
        if (hh == need) { exact = true; T = P << shift; break; }
        T = P;
    }
    int tie = LP;
    if (!exact) {
        int run = 0; tie = -1;
#pragma unroll
        for (int r = 0; r < NREG; ++r) { unsigned long long mk = __ballot(k[r] == T); const int pc = (int)__popcll(mk);
            if (tie < 0 && pc > 0 && run + pc >= need) { int kth = need - run; while (kth > 1) { mk &= mk - 1; --kth; } tie = r * 64 + (int)__builtin_ctzll(mk); }
            run += pc; }
    }
    unsigned long long* mp = mrow;
    if (exact) {
#pragma unroll
        for (int r = 0; r < NREG; ++r) { const unsigned long long mk = __ballot(k[r] >= T); if (lane == 0) *mp = mk; mp += LP; asm volatile("" : "+v"(mp)); }
    } else {
#pragma unroll
        for (int r = 0; r < NREG; ++r) { const int s = r * 64 + lane;
            const bool sl = (k[r] > T || (k[r] == T && s <= tie));
            const unsigned long long mk = __ballot(sl && s < n);
            if (lane == 0) *mp = mk; mp += LP; asm volatile("" : "+v"(mp)); }
    }
    *(LAS v4u*)(hist + 4 * lane) = (v4u){0u, 0u, 0u, 0u};
}
DI void phase_select(const Ctx& c, const bf16_t* IQ, const bf16_t* IWC, const bf16_t* IKC, unsigned long long* maskw) {
    LAS unsigned char* lds = (LAS unsigned char*)c.lds;
    const int lane = c.lane, w = c.wave, r32 = lane & 31, hi = lane >> 5;
    LAS unsigned* hist = (LAS unsigned*)(lds + 8 * LP * 4) + w * 320;
    *(LAS v4u*)(hist + 4 * lane) = (v4u){0u, 0u, 0u, 0u};
    asm volatile("s_waitcnt lgkmcnt(0)" ::: "memory"); __builtin_amdgcn_s_barrier(); asm volatile("" ::: "memory");
    for (int u = c.bid; u < MP / 8; u += c.G) {
        const int b = u / (LP / 8), t0 = (u % (LP / 8)) * 8, t = t0 + w;
        unsigned long long* mrow = maskw + (size_t)b * 66 * LP + t;
        if (t0 + 8 <= TOPK || t0 >= LTOT) {
            for (int j = lane; j < 66; j += 64) { const int rem = t + 1 - 64 * j; mrow[(size_t)j * LP] = rem >= 64 ? ~0ull : (rem <= 0 ? 0ull : ((1ull << rem) - 1ull)); }
            continue;
        }
        const int nmax = t0 + 8;
        bf16x8_t afr[2][2]; v4u wq[2][2];
        { const int qq = 2 * ((r32 >> 2) & 1) + (r32 >> 4), hh = (r32 & 3) + 4 * ((r32 >> 3) & 1);
#pragma unroll
          for (int rb = 0; rb < 2; ++rb)
#pragma unroll
              for (int kk = 0; kk < 2; ++kk) afr[rb][kk] = *(const bf16x8_t*)(IQ + ((size_t)b * LP + t0 + 4 * rb + qq) * 256 + hh * 32 + 16 * kk + 8 * hi);
#pragma unroll
          for (int rb = 0; rb < 2; ++rb)
#pragma unroll
              for (int e = 0; e < 2; ++e) wq[rb][e] = *(const v4u*)(IWC + ((size_t)b * LP + t0 + 4 * rb + 2 * hi + e) * 8); }
        const int nkb = (nmax + 31) >> 5;
        for (int kb0 = w; kb0 < nkb; kb0 += 32) {
            bf16x8_t bfr[4][2];
#pragma unroll
            for (int q = 0; q < 4; ++q) { int kbq = kb0 + 8 * q; if (kbq >= nkb) kbq = kb0;
                const bf16_t* kp = IKC + ((size_t)(b * 4 + hi) * LP + kbq * 32 + r32) * 8; bfr[q][0] = *(const bf16x8_t*)kp; bfr[q][1] = *(const bf16x8_t*)(kp + (size_t)2 * LP * 8); }
#pragma unroll
            for (int q = 0; q < 4; ++q) { const int kb = kb0 + 8 * q;
                if (kb < nkb) {
#pragma unroll
                    for (int rb = 0; rb < 2; ++rb) {
                        f32x16 acc = {0.f, 0.f, 0.f, 0.f, 0.f, 0.f, 0.f, 0.f, 0.f, 0.f, 0.f, 0.f, 0.f, 0.f, 0.f, 0.f};
                        acc = __builtin_amdgcn_mfma_f32_32x32x16_bf16(afr[rb][0], bfr[q][0], acc, 0, 0, 0);
                        acc = __builtin_amdgcn_mfma_f32_32x32x16_bf16(afr[rb][1], bfr[q][1], acc, 0, 0, 0);
#pragma unroll
                        for (int e = 0; e < 2; ++e) { float sc = 0.f;
#pragma unroll
                            for (int h = 0; h < 8; ++h) { const unsigned ww = h < 2 ? wq[rb][e].x : h < 4 ? wq[rb][e].y : h < 6 ? wq[rb][e].z : wq[rb][e].w; sc += ((h & 1) ? hi2f(ww) : lo2f(ww)) * fmaxf(acc[8 * e + h], 0.f); }
                            const unsigned key = fkey(sc); const int qrow_ = 4 * rb + 2 * hi + e;
                            ((LAS unsigned*)lds)[qrow_ * LP + kb * 32 + r32] = key;
                            if (kb * 32 + r32 <= t0 + qrow_) __hip_atomic_fetch_add((LAS unsigned*)(lds + 8 * LP * 4) + qrow_ * 320 + (key >> 24), 1u, __ATOMIC_RELAXED, __HIP_MEMORY_SCOPE_WORKGROUP); }
                    }
                }
            }
        }
        asm volatile("s_waitcnt lgkmcnt(0)" ::: "memory"); __builtin_amdgcn_s_barrier(); asm volatile("" ::: "memory");
        { const LAS unsigned* kbuf = (const LAS unsigned*)lds + w * LP; const int n = t + 1;
          if (n <= 17 * 64) select_row<17>(kbuf, hist, n, lane, mrow); else if (n <= 33 * 64) select_row<33>(kbuf, hist, n, lane, mrow);
          else if (n <= 50 * 64) select_row<50>(kbuf, hist, n, lane, mrow); else select_row<66>(kbuf, hist, n, lane, mrow); }
        asm volatile("s_waitcnt lgkmcnt(0)" ::: "memory"); __builtin_amdgcn_s_barrier(); asm volatile("" ::: "memory");
    }
}

constexpr float NEG_BIG = -1.0e30f;
constexpr int ATT_LUT_OFF = 122880;
#define SGB(mask, n) __builtin_amdgcn_sched_group_barrier((mask), (n), 0)
template <int DQK, bool DSA>
DI void attn_unit(LAS unsigned char* lds, int b, int qt, int hp, const bf16_t* Q, int qpitch, const bf16_t* K, int kpitch, const bf16_t* VT, bf16_t* O,
                  const unsigned long long* maskw, const float* lut) {
    constexpr int NPK = DQK / 8, KB = 2 * NPK * 1024, BUF = KB + 16 * 1024;
    int tid_ = threadIdx.x; asm volatile("" : "+v"(tid_));
    const int tid = tid_, lane = tid & 63, w = __builtin_amdgcn_readfirstlane(tid >> 6), r32 = lane & 31, hi = lane >> 5;
    const int hh = w >> 2, head = 2 * hp + hh, q0 = qt * 128 + (w & 3) * 32, qrow = q0 + r32;
    const size_t rowb = (size_t)b * LP;
    const int NT = 2 * qt + 2;
    if (DSA) { if (tid < 256) ((LAS float*)(lds + ATT_LUT_OFF))[tid] = lut[(tid & 127) * 8 + 2 * hp + (tid >> 7)] - lut[127 * 8 + 2 * hp + (tid >> 7)]; }
    const LAS float* lutw = (const LAS float*)(lds + ATT_LUT_OFF) + hh * 128;
    constexpr int NG = NPK / 4;
    auto issue = [&](int j, int buf) {
        const int key0 = j * 64; LAS unsigned char* base = lds + buf * BUF;
        const int kk = lane >> 2, c4 = (lane & 3) ^ ((kk >> 2) & 3);
#pragma unroll
        for (int i = 0; i < 2 * NPK / 8; ++i) { const int pi = w + 8 * i, ph = pi / NPK, rem = pi % NPK, kg = rem / NG, g = rem % NG;
            __builtin_amdgcn_global_load_lds((const unsigned*)(K + (rowb + key0 + kg * 16 + kk) * kpitch + (2 * hp + ph) * DQK + (4 * g + c4) * 8), (LAS unsigned*)(base + (ph * NPK + kg * NG + g) * 1024), 16, 0, 0); }
        const int dd = lane >> 3;
#pragma unroll
        for (int i = 0; i < 2; ++i) { const int pi = w + 8 * i, ph = pi >> 3, blk = pi & 7; const int kp = (lane & 7) ^ (dd >> 1) ^ ((blk & 1) << 2);
            __builtin_amdgcn_global_load_lds((const unsigned*)(VT + ((size_t)((b * 8 + 2 * hp + ph) * 64 + blk * 8 + dd)) * LP + key0 + kp * 8), (LAS unsigned*)(base + KB + (ph * 8 + blk) * 1024), 16, 0, 0); }
    };
    const int kk_r = r32 & 15;
    const int koffE = (r32 >> 4) * NG * 1024 + kk_r * 64 + ((hi ^ ((kk_r >> 2) & 3)) << 4);
    const int t_r = (((r32 & 7) >> 1) ^ (((r32 >> 3) & 1) << 2));
    const int vbl = (r32 >> 3) * 1024 + (r32 & 7) * 128 + ((hi ^ (t_r & 1)) << 4), t6s = (t_r & 6) << 4;
    issue(0, 0); issue(1, 1);
    bf16x8_t qf[DQK / 16];
#pragma unroll
    for (int d0 = 0; d0 < DQK / 16; ++d0) qf[d0] = *(const bf16x8_t*)(Q + (rowb + qrow) * qpitch + head * DQK + 16 * d0 + 8 * hi);
    f32x16 o0, o1, s0, s1, n0, n1;
#pragma unroll
    for (int r = 0; r < 16; ++r) { o0[r] = 0.f; o1[r] = 0.f; }
    float lrun = 0.f;
    auto post = [&](f32x16& a0, f32x16& a1, int j) {
        const int key0 = j * 64;
        if (DSA) {
            if (q0 - (key0 + 63) < 113) {
#pragma unroll
                for (int r = 0; r < 16; ++r) { const int kk = key0 + (r & 3) + 8 * (r >> 2) + 4 * hi; int d0 = qrow - kk, d1 = d0 - 32;
                    d0 = d0 < 0 ? 0 : (d0 > 127 ? 127 : d0); d1 = d1 < 0 ? 0 : (d1 > 127 ? 127 : d1); a0[r] += lutw[d0]; a1[r] += lutw[d1]; } }
        }
        if (key0 + 63 > q0) {
#pragma unroll
            for (int r = 0; r < 16; ++r) { const int kk = key0 + (r & 3) + 8 * (r >> 2) + 4 * hi; if (kk > qrow) a0[r] = NEG_BIG; if (kk + 32 > qrow) a1[r] = NEG_BIG; }
        }
    };
#define ATT_QK(a0, a1, sl, mw_) do { const LAS unsigned char* kbase_ = lds + (sl) * BUF + hh * NPK * 1024; \
        if (DSA) { const int nlo_ = (int)~(unsigned)((mw_) >> (4 * hi)), nhi_ = (int)~(unsigned)((mw_) >> (32 + 4 * hi)); \
            _Pragma("unroll") for (int r = 0; r < 16; ++r) { const int bitp_ = (r & 3) + 8 * (r >> 2); \
                a0[r] = __int_as_float(__builtin_amdgcn_sbfe(nlo_, bitp_, 1) & __float_as_int(NEG_BIG)); a1[r] = __int_as_float(__builtin_amdgcn_sbfe(nhi_, bitp_, 1) & __float_as_int(NEG_BIG)); } } \
        else { _Pragma("unroll") for (int r = 0; r < 16; ++r) { a0[r] = 0.f; a1[r] = 0.f; } } \
        _Pragma("unroll") for (int d0 = 0; d0 < DQK / 16; ++d0) { \
            const int ko_ = ((d0 & 1) ? (koffE ^ 32) : koffE) + (d0 >> 1) * 1024; \
            const bf16x8_t k0_ = *(const LAS bf16x8_t*)(kbase_ + ko_), k1_ = *(const LAS bf16x8_t*)(kbase_ + ko_ + 2 * NG * 1024); \
            a0 = __builtin_amdgcn_mfma_f32_32x32x16_bf16(k0_, qf[d0], a0, 0, 0, 0); a1 = __builtin_amdgcn_mfma_f32_32x32x16_bf16(k1_, qf[d0], a1, 0, 0, 0); } } while (0)
#define ATT_SOFTMAX(S0_, S1_) do { float ls_ = 0.f; \
        _Pragma("unroll") for (int r = 0; r < 16; ++r) { S0_[r] = __builtin_amdgcn_exp2f(S0_[r]); S1_[r] = __builtin_amdgcn_exp2f(S1_[r]); ls_ += S0_[r] + S1_[r]; } \
        lrun += ls_; } while (0)
#define ATT_PV(S0_, S1_, sl) do { const LAS unsigned char* vbase_ = lds + (sl) * BUF + KB + hh * 8 * 1024; \
        _Pragma("unroll") for (int kb = 0; kb < 2; ++kb) _Pragma("unroll") for (int s2 = 0; s2 < 2; ++s2) { v4u pw_; \
            if (kb == 0) { pw_.x = pk2(S0_[8 * s2], S0_[8 * s2 + 1]); pw_.y = pk2(S0_[8 * s2 + 2], S0_[8 * s2 + 3]); pw_.z = pk2(S0_[8 * s2 + 4], S0_[8 * s2 + 5]); pw_.w = pk2(S0_[8 * s2 + 6], S0_[8 * s2 + 7]); } \
            else { pw_.x = pk2(S1_[8 * s2], S1_[8 * s2 + 1]); pw_.y = pk2(S1_[8 * s2 + 2], S1_[8 * s2 + 3]); pw_.z = pk2(S1_[8 * s2 + 4], S1_[8 * s2 + 5]); pw_.w = pk2(S1_[8 * s2 + 6], S1_[8 * s2 + 7]); } \
            const bf16x8_t pf_ = __builtin_bit_cast(bf16x8_t, pw_); \
            const LAS unsigned char* vp_ = vbase_ + vbl + ((32 * (2 * kb + s2)) ^ t6s); \
            const bf16x8_t v0_ = *(const LAS bf16x8_t*)vp_, v1_ = *(const LAS bf16x8_t*)(vp_ + 4096); \
            o0 = __builtin_amdgcn_mfma_f32_32x32x16_bf16(v0_, pf_, o0, 0, 0, 0); o1 = __builtin_amdgcn_mfma_f32_32x32x16_bf16(v1_, pf_, o1, 0, 0, 0); } } while (0)
    asm volatile("s_waitcnt vmcnt(0) lgkmcnt(0)" ::: "memory"); __builtin_amdgcn_s_barrier(); asm volatile("" ::: "memory");
    unsigned long long mwn = ~0ull;
    { unsigned long long mw0 = ~0ull; if (DSA) { mw0 = maskw[(size_t)b * 66 * LP + qrow]; if (NT > 1) mwn = maskw[((size_t)b * 66 + 1) * LP + qrow]; }
      ATT_QK(s0, s1, 0, mw0); post(s0, s1, 0); }
    int slot = 0;
#define ATT_STEP(S0_, S1_, N0_, N1_, jj) do { const int j_ = (jj); const int slot1 = slot == 2 ? 0 : slot + 1, slot2 = slot1 == 2 ? 0 : slot1 + 1; \
        if (j_ > 0) { asm volatile("s_waitcnt vmcnt(0) lgkmcnt(0)" ::: "memory"); __builtin_amdgcn_s_barrier(); asm volatile("" ::: "memory"); }     \
        if (j_ + 2 < NT) issue(j_ + 2, slot2); \
        const unsigned long long mw_s = mwn; \
        if (DSA) { if (j_ + 2 < NT) mwn = maskw[((size_t)b * 66 + j_ + 2) * LP + qrow]; } \
        ATT_QK(N0_, N1_, slot1, mw_s); \
        ATT_SOFTMAX(S0_, S1_); \
        ATT_PV(S0_, S1_, slot); \
        post(N0_, N1_, j_ + 1); \
        slot = slot1; } while (0)
    int j = 0;
    for (; j + 2 < NT - 1; j += 2) { ATT_STEP(s0, s1, n0, n1, j); ATT_STEP(n0, n1, s0, s1, j + 1); }
    if (j + 1 < NT) {
        ATT_STEP(s0, s1, n0, n1, j);
        ATT_SOFTMAX(n0, n1); ATT_PV(n0, n1, slot);
    } else { ATT_SOFTMAX(s0, s1); ATT_PV(s0, s1, slot); }
#undef ATT_STEP
#undef ATT_QK
#undef ATT_SOFTMAX
#undef ATT_PV
    lrun += __shfl_xor(lrun, 32);
    const float inv = 1.0f / lrun;
    bf16_t* op = O + (rowb + qrow) * D + head * 64 + 4 * hi;
#pragma unroll
    for (int g = 0; g < 4; ++g) {
        v2u a, bq; a.x = pk2(o0[4 * g] * inv, o0[4 * g + 1] * inv); a.y = pk2(o0[4 * g + 2] * inv, o0[4 * g + 3] * inv);
        bq.x = pk2(o1[4 * g] * inv, o1[4 * g + 1] * inv); bq.y = pk2(o1[4 * g + 2] * inv, o1[4 * g + 3] * inv);
        *(v2u*)(op + 8 * g) = a; *(v2u*)(op + 32 + 8 * g) = bq; }
    asm volatile("s_waitcnt vmcnt(0) lgkmcnt(0)" ::: "memory"); __builtin_amdgcn_s_barrier(); asm volatile("" ::: "memory");
}
template <int DQK, bool DSA>
DI void attn_unit2(LAS unsigned char* lds, int b, int qt, int hp, const bf16_t* Q, int qpitch, const bf16_t* K, int kpitch, const bf16_t* VT, bf16_t* O,
                   const unsigned long long* maskw, const float* lut) {
    constexpr int NPK = DQK / 8, KB = 2 * NPK * 1024, BUF = KB + 16 * 1024;
    int tid_ = threadIdx.x; asm volatile("" : "+v"(tid_));
    const int tid = tid_, lane = tid & 63, w = __builtin_amdgcn_readfirstlane(tid >> 6), r32 = lane & 31, hi = lane >> 5;
    const int hh = w >> 2, head = 2 * hp + hh, q0 = qt * 256 + (w & 3) * 64;
    const bool live = q0 < LP;
    const int qrowA = live ? q0 + r32 : r32, qrowB = qrowA + 32;
    const size_t rowb = (size_t)b * LP;
    const int NT = (4 * qt + 4) < (LP / 64) ? (4 * qt + 4) : (LP / 64);
    if (DSA) { if (tid < 256) ((LAS float*)(lds + ATT_LUT_OFF))[tid] = lut[(tid & 127) * 8 + 2 * hp + (tid >> 7)] - lut[127 * 8 + 2 * hp + (tid >> 7)]; }
    const LAS float* lutw = (const LAS float*)(lds + ATT_LUT_OFF) + hh * 128;
    constexpr int NG = NPK / 4;
    auto issue = [&](int j, int buf) {
        const int key0 = j * 64; LAS unsigned char* base = lds + buf * BUF;
        const int kk = lane >> 2, c4 = (lane & 3) ^ ((kk >> 2) & 3);
#pragma unroll
        for (int i = 0; i < 2 * NPK / 8; ++i) { const int pi = w + 8 * i, ph = pi / NPK, rem = pi % NPK, kg = rem / NG, g = rem % NG;
            __builtin_amdgcn_global_load_lds((const unsigned*)(K + (rowb + key0 + kg * 16 + kk) * kpitch + (2 * hp + ph) * DQK + (4 * g + c4) * 8), (LAS unsigned*)(base + (ph * NPK + kg * NG + g) * 1024), 16, 0, 0); }
        const int dd = lane >> 3;
#pragma unroll
        for (int i = 0; i < 2; ++i) { const int pi = w + 8 * i, ph = pi >> 3, blk = pi & 7; const int kp = (lane & 7) ^ (dd >> 1) ^ ((blk & 1) << 2);
            __builtin_amdgcn_global_load_lds((const unsigned*)(VT + ((size_t)((b * 8 + 2 * hp + ph) * 64 + blk * 8 + dd)) * LP + key0 + kp * 8), (LAS unsigned*)(base + KB + (ph * 8 + blk) * 1024), 16, 0, 0); }
    };
    const int kk_r = r32 & 15;
    const int koffE = (r32 >> 4) * NG * 1024 + kk_r * 64 + ((hi ^ ((kk_r >> 2) & 3)) << 4);
    const int t_r = (((r32 & 7) >> 1) ^ (((r32 >> 3) & 1) << 2));
    const int vbl = (r32 >> 3) * 1024 + (r32 & 7) * 128 + ((hi ^ (t_r & 1)) << 4), t6s = (t_r & 6) << 4;
    issue(0, 0); issue(1, 1);
    bf16x8_t qfA[DQK / 16], qfB[DQK / 16];
#pragma unroll
    for (int d0 = 0; d0 < DQK / 16; ++d0) { qfA[d0] = *(const bf16x8_t*)(Q + (rowb + qrowA) * qpitch + head * DQK + 16 * d0 + 8 * hi); qfB[d0] = *(const bf16x8_t*)(Q + (rowb + qrowB) * qpitch + head * DQK + 16 * d0 + 8 * hi); }
    f32x16 oA0, oA1, oB0, oB1, sA0, sA1, sB0, sB1;
#pragma unroll
    for (int r = 0; r < 16; ++r) { oA0[r] = 0.f; oA1[r] = 0.f; oB0[r] = 0.f; oB1[r] = 0.f; }
    float lA = 0.f, lB = 0.f;
    auto post = [&](f32x16& a0, f32x16& a1, int key0, int qb, int qr) {
        if (DSA) {
            if (qb - (key0 + 63) < 113) {
#pragma unroll
                for (int r = 0; r < 16; ++r) { const int kk = key0 + (r & 3) + 8 * (r >> 2) + 4 * hi; int d0 = qr - kk, d1 = d0 - 32;
                    d0 = d0 < 0 ? 0 : (d0 > 127 ? 127 : d0); d1 = d1 < 0 ? 0 : (d1 > 127 ? 127 : d1); a0[r] += lutw[d0]; a1[r] += lutw[d1]; } }
        }
        if (key0 + 63 > qb) {
#pragma unroll
            for (int r = 0; r < 16; ++r) { const int kk = key0 + (r & 3) + 8 * (r >> 2) + 4 * hi; if (kk > qr) a0[r] = NEG_BIG; if (kk + 32 > qr) a1[r] = NEG_BIG; }
        }
    };
#define ATT2_INIT(a0, a1, mw_) do { if (DSA) { const int nlo_ = (int)~(unsigned)((mw_) >> (4 * hi)), nhi_ = (int)~(unsigned)((mw_) >> (32 + 4 * hi)); \
            _Pragma("unroll") for (int r = 0; r < 16; ++r) { const int bitp_ = (r & 3) + 8 * (r >> 2); \
                a0[r] = __int_as_float(__builtin_amdgcn_sbfe(nlo_, bitp_, 1) & __float_as_int(NEG_BIG)); a1[r] = __int_as_float(__builtin_amdgcn_sbfe(nhi_, bitp_, 1) & __float_as_int(NEG_BIG)); } } \
        else { _Pragma("unroll") for (int r = 0; r < 16; ++r) { a0[r] = 0.f; a1[r] = 0.f; } } } while (0)
#define ATT2_EXP(S0_, S1_, L_) do { float ls_ = 0.f; \
        _Pragma("unroll") for (int r = 0; r < 16; ++r) { S0_[r] = __builtin_amdgcn_exp2f(S0_[r]); S1_[r] = __builtin_amdgcn_exp2f(S1_[r]); ls_ += S0_[r] + S1_[r]; } \
        L_ += ls_; } while (0)
#define ATT2_PACK(S_, s2) ({ v4u pw_; pw_.x = pk2(S_[8 * (s2)], S_[8 * (s2) + 1]); pw_.y = pk2(S_[8 * (s2) + 2], S_[8 * (s2) + 3]); pw_.z = pk2(S_[8 * (s2) + 4], S_[8 * (s2) + 5]); pw_.w = pk2(S_[8 * (s2) + 6], S_[8 * (s2) + 7]); __builtin_bit_cast(bf16x8_t, pw_); })
    asm volatile("s_waitcnt vmcnt(0) lgkmcnt(0)" ::: "memory"); __builtin_amdgcn_s_barrier(); asm volatile("" ::: "memory");
    unsigned long long mwA = ~0ull, mwB = ~0ull;
    if (DSA && live) { mwA = maskw[(size_t)b * 66 * LP + qrowA]; mwB = maskw[(size_t)b * 66 * LP + qrowB]; }
    int slot = 0;
    for (int j = 0; j < NT; ++j) {
        const int slot1 = slot == 2 ? 0 : slot + 1, slot2 = slot1 == 2 ? 0 : slot1 + 1;
        if (j > 0) { asm volatile("s_waitcnt vmcnt(0) lgkmcnt(0)" ::: "memory"); __builtin_amdgcn_s_barrier(); asm volatile("" ::: "memory"); }
        if (j + 2 < NT) issue(j + 2, slot2);
        const unsigned long long mA = mwA, mB = mwB;
        if (DSA && live && j + 1 < NT) { mwA = maskw[((size_t)b * 66 + j + 1) * LP + qrowA]; mwB = maskw[((size_t)b * 66 + j + 1) * LP + qrowB]; }
        const int key0 = j * 64;
        if (live && key0 <= q0 + 63) {
            ATT2_INIT(sA0, sA1, mA); ATT2_INIT(sB0, sB1, mB);
            { const LAS unsigned char* kbase_ = lds + slot * BUF + hh * NPK * 1024;
#pragma unroll
              for (int d0 = 0; d0 < DQK / 16; ++d0) {
                  const int ko_ = ((d0 & 1) ? (koffE ^ 32) : koffE) + (d0 >> 1) * 1024;
                  const bf16x8_t k0_ = *(const LAS bf16x8_t*)(kbase_ + ko_), k1_ = *(const LAS bf16x8_t*)(kbase_ + ko_ + 2 * NG * 1024);
                  sA0 = __builtin_amdgcn_mfma_f32_32x32x16_bf16(k0_, qfA[d0], sA0, 0, 0, 0); sA1 = __builtin_amdgcn_mfma_f32_32x32x16_bf16(k1_, qfA[d0], sA1, 0, 0, 0);
                  sB0 = __builtin_amdgcn_mfma_f32_32x32x16_bf16(k0_, qfB[d0], sB0, 0, 0, 0); sB1 = __builtin_amdgcn_mfma_f32_32x32x16_bf16(k1_, qfB[d0], sB1, 0, 0, 0); } }
            post(sA0, sA1, key0, q0, qrowA); ATT2_EXP(sA0, sA1, lA);
            post(sB0, sB1, key0, q0 + 32, qrowB); ATT2_EXP(sB0, sB1, lB);
            { const LAS unsigned char* vbase_ = lds + slot * BUF + KB + hh * 8 * 1024;
#pragma unroll
              for (int kb = 0; kb < 2; ++kb)
#pragma unroll
                  for (int s2 = 0; s2 < 2; ++s2) {
                      const bf16x8_t pA_ = kb == 0 ? ATT2_PACK(sA0, s2) : ATT2_PACK(sA1, s2), pB_ = kb == 0 ? ATT2_PACK(sB0, s2) : ATT2_PACK(sB1, s2);
                      const LAS unsigned char* vp_ = vbase_ + vbl + ((32 * (2 * kb + s2)) ^ t6s);
                      const bf16x8_t v0_ = *(const LAS bf16x8_t*)vp_, v1_ = *(const LAS bf16x8_t*)(vp_ + 4096);
                      oA0 = __builtin_amdgcn_mfma_f32_32x32x16_bf16(v0_, pA_, oA0, 0, 0, 0); oA1 = __builtin_amdgcn_mfma_f32_32x32x16_bf16(v1_, pA_, oA1, 0, 0, 0);
                      oB0 = __builtin_amdgcn_mfma_f32_32x32x16_bf16(v0_, pB_, oB0, 0, 0, 0); oB1 = __builtin_amdgcn_mfma_f32_32x32x16_bf16(v1_, pB_, oB1, 0, 0, 0); } }
        }
        slot = slot1;
    }
#undef ATT2_INIT
#undef ATT2_EXP
#undef ATT2_PACK
    if (live) {
        lA += __shfl_xor(lA, 32); lB += __shfl_xor(lB, 32);
        const float invA = 1.0f / lA, invB = 1.0f / lB;
        bf16_t* opA = O + (rowb + qrowA) * D + head * 64 + 4 * hi; bf16_t* opB = O + (rowb + qrowB) * D + head * 64 + 4 * hi;
#pragma unroll
        for (int g = 0; g < 4; ++g) {
            v2u a, bq; a.x = pk2(oA0[4 * g] * invA, oA0[4 * g + 1] * invA); a.y = pk2(oA0[4 * g + 2] * invA, oA0[4 * g + 3] * invA);
            bq.x = pk2(oA1[4 * g] * invA, oA1[4 * g + 1] * invA); bq.y = pk2(oA1[4 * g + 2] * invA, oA1[4 * g + 3] * invA);
            *(v2u*)(opA + 8 * g) = a; *(v2u*)(opA + 32 + 8 * g) = bq;
            a.x = pk2(oB0[4 * g] * invB, oB0[4 * g + 1] * invB); a.y = pk2(oB0[4 * g + 2] * invB, oB0[4 * g + 3] * invB);
            bq.x = pk2(oB1[4 * g] * invB, oB1[4 * g + 1] * invB); bq.y = pk2(oB1[4 * g + 2] * invB, oB1[4 * g + 3] * invB);
            *(v2u*)(opB + 8 * g) = a; *(v2u*)(opB + 32 + 8 * g) = bq; }
    }
    asm volatile("s_waitcnt vmcnt(0) lgkmcnt(0)" ::: "memory"); __builtin_amdgcn_s_barrier(); asm volatile("" ::: "memory");
}
template <int DQK, bool DSA>
DI void attn_phase2(const Ctx& c, const bf16_t* Q, int qpitch, const bf16_t* K, int kpitch, const bf16_t* VT, bf16_t* O, const unsigned long long* maskw, const float* lut) {
    constexpr int NLV = (LP + 255) / 256, NU = NB * NLV * 4;
    for (int rnd = 0;; ++rnd) {
        const int u = rnd * c.G + ((rnd & 1) ? (c.G - 1 - c.bid) : c.bid); if (u >= NU) { if (rnd * c.G >= NU) break; else continue; }
        const int qt = NLV - 1 - u / 32, b = (u % 32) >> 2, hp = u & 3;
        attn_unit2<DQK, DSA>((LAS unsigned char*)c.lds, b, qt, hp, Q, qpitch, K, kpitch, VT, O, maskw, lut);
    }
}
template <int DQK, bool DSA>
DI void attn_phase(const Ctx& c, const bf16_t* Q, int qpitch, const bf16_t* K, int kpitch, const bf16_t* VT, bf16_t* O, const unsigned long long* maskw, const float* lut) {
    constexpr int NU = NB * 33 * 4;
    for (int rnd = 0;; ++rnd) {
        const int u = rnd * c.G + ((rnd & 1) ? (c.G - 1 - c.bid) : c.bid); if (u >= NU) { if (rnd * c.G >= NU) break; else continue; }
        const int qt = 32 - u / 32, b = (u % 32) >> 2, hp = u & 3;
        attn_unit<DQK, DSA>((LAS unsigned char*)c.lds, b, qt, hp, Q, qpitch, K, kpitch, VT, O, maskw, lut);
    }
}

enum { PH_PROLOGUE = 0, PH_MIXIN, PH_UP, PH_EW4, PH_ATTN, PH_MIXOUT, PH_NORM1, PH_FFN1, PH_FFN2, PH_NORM2, PH_WIN, PH_CONV, PH_WOUT, PH_ROUTE, PH_SCATTER, PH_MOE1A, PH_MOE2A, PH_MOE1B, PH_MOE2B, PH_FIX, NPH };

__global__ void __launch_bounds__(512, 2) mk_fwd(Args args) {
    extern __shared__ __attribute__((aligned(16))) unsigned char lds_raw[];
    Ctx c;
    c.tid = threadIdx.x; c.lane = c.tid & 63; c.wave = __builtin_amdgcn_readfirstlane(c.tid >> 6);
    c.G = gridDim.x; c.bid = blockIdx.x; c.gw = c.bid * 8 + c.wave; c.ngw = c.G * 8;
    c.lds = lds_raw; c.wscr = lds_raw + c.wave * WSCR;
    unsigned char* ws = args.ws; unsigned char* ob = (unsigned char*)args.out;
    gu32* ctl = (gu32*)(ws + WS_CTL);
    volatile LAS unsigned* MISC = (volatile LAS unsigned*)((LAS unsigned char*)lds_raw + MISC_OFF);
    if (c.tid < 32) MISC[c.tid] = 0u;
    __syncthreads();
#if MK_ONE_LAUNCH
    XcdBarrier bar = xcd_barrier_post((unsigned*)(ws + WS_CTL) + CW_BAR, MISC + 8);
#define GRID_BAR() xcd_barrier(bar)
#else
#define GRID_BAR() do {} while (0)
#endif
    const int lo = args.ph_lo, hi = args.ph_hi;
#ifdef ONLY_PH
#define IN(k) ((k) == ONLY_PH && lo <= (k) && (k) < hi)
#else
#define IN(k) (lo <= (k) && (k) < hi)
#endif
#define SEAM(k) do { if (IN(k) && IN((k) + 1)) GRID_BAR(); } while (0)
    const float* const* in = args.in;
#define WSP(T, off) ((T*)(ws + (off)))
#define CNT (((unsigned*)(ws + WS_CTL)) + CW_CNT)

    if (IN(PH_PROLOGUE)) {
        conv_matrix(c, SrcMix{in[4]}, D, MIXN, WSP(bf16_t, WS_WMIX));
        conv_matrix(c, SrcPlainG{in[7], 768, in[5]}, QR, 768, WSP(bf16_t, WS_WUQ));
        conv_matrix(c, SrcPlainG{in[8], 1024, in[6]}, KVR, 1024, WSP(bf16_t, WS_WUKV));
        { int rot = 0;
        conv_fast<false>(c, RowPlain{in[13], D}, D, D, WSP(bf16_t, WS_WMO), 1.f, rot);
        conv_fast<false>(c, RowGlu{in[15], in[16], DFF}, D, 2 * DFF, WSP(bf16_t, WS_W13), 1.f, rot);
        conv_fast<false>(c, RowPlain{in[17], D}, DFF, D, WSP(bf16_t, WS_W2), 1.f, rot);
        conv_fast<false>(c, RowGlu{in[19] + 1024, in[19] + 2048, 3072}, D, 2048, WSP(bf16_t, WS_WIN), 1.f, rot);
        conv_fast<false>(c, RowPlain{in[19], 3072}, D, 1024, WSP(bf16_t, WS_WIN) + (size_t)2048 * D, 1.f, rot);
        conv_fast<false>(c, RowPlain{in[21], D}, D, D, WSP(bf16_t, WS_WOUT), 1.f, rot); }
        if (c.bid == 0) { float* lut = WSP(float, TAB_LUT); for (int i = c.tid; i < 1024; i += 512) { const int d = i >> 3, hh = i & 7; int bk;
            if (d < 16) bk = d; else { bk = 16; const int th[15] = {19, 21, 24, 27, 31, 35, 40, 46, 52, 59, 67, 77, 87, 99, 113};
#pragma unroll
                for (int k = 0; k < 15; ++k) bk += (d >= th[k]) ? 1 : 0; }
            lut[i] = in[2][bk * 8 + hh] * LOG2E; } }
        phase_prologue_rows(c, in[0], in[1], in[3], WSP(bf16_t, WS_H), WSP(bf16_t, WS_XN));
    }
    SEAM(PH_PROLOGUE);
    if (IN(PH_MIXIN)) {
        GemmP g{WSP(bf16_t, WS_XN), D, nullptr, D, D}; StaticSched S; S.init(MP / 256, MIXN / 256, c.G, c.bid, WSP(bf16_t, WS_WMIX), D, 0);
        gemm_phase<false>(c, g, S, EpiRoute{ws, in[11], in[12]});
        { int w, nw; if (idle_slot(c, NWG_MIXIN, w, nw)) moe_conv_items<0>(c, in, ws, 0, idle_items(c.G, NWG_MIXIN, NE * MOE_IT13), w, nw); }
    }
    SEAM(PH_MIXIN);
    if (IN(PH_UP)) {
        for (int q = 0; q < 2; ++q) {
            GemmP g{WSP(bf16_t, WS_LAT) + (q == 0 ? 256 : 0), 768, nullptr, q == 0 ? QR : KVR, q == 0 ? QR : KVR};
            StaticSched S; S.init(MP / 256, q == 0 ? 3 : 4, c.G, c.bid, q == 0 ? WSP(bf16_t, WS_WUQ) : WSP(bf16_t, WS_WUKV), q == 0 ? QR : KVR, 0);
            gemm_phase<false>(c, g, S, EpiUp{(bf16_t*)(ob + (q == 0 ? OUT_QM : OUT_KV)), q == 0 ? MLAW : 1024, WSP(float, WS_SSP), q == 0 ? 1 : 0});
        }
    }
    SEAM(PH_UP);
    if (IN(PH_EW4)) { phase_select(c, WSP(bf16_t, WS_IQ), WSP(bf16_t, WS_IWC), WSP(bf16_t, WS_IKC), WSP(unsigned long long, WS_MASK));
        phase_ew4(c, (bf16_t*)(ob + OUT_QM), (const bf16_t*)(ob + OUT_KV), WSP(bf16_t, WS_LAT), WSP(bf16_t, WS_LAT), in[9], in[10]);
        transpose_v(c, (const bf16_t*)(ob + OUT_KV), 1024, 64, 128, WSP(bf16_t, WS_VMT)); transpose_v(c, WSP(bf16_t, WS_DV), 512, 0, 64, WSP(bf16_t, WS_VDT)); }
    SEAM(PH_EW4);
    if (IN(PH_ATTN)) {
#if NAIVE_ATTN
        phase_mla_naive(c, (const bf16_t*)(ob + OUT_QM), WSP(bf16_t, WS_LAT), WSP(bf16_t, WS_VMT), WSP(bf16_t, WS_XN));
        phase_dsa_naive(c, WSP(bf16_t, WS_DQ), WSP(bf16_t, WS_DK), WSP(bf16_t, WS_DV), WSP(bf16_t, WS_IQ), WSP(bf16_t, WS_IK), WSP(float, WS_IW), WSP(float, TAB_LUT), WSP(bf16_t, WS_XN));
#else
        attn_phase2<96, false>(c, (const bf16_t*)(ob + OUT_QM), MLAW, WSP(bf16_t, WS_LAT), MLAW, WSP(bf16_t, WS_VMT), WSP(bf16_t, WS_XN), nullptr, nullptr);
        attn_phase2<64, true>(c, WSP(bf16_t, WS_DQ), DW, WSP(bf16_t, WS_DK), DW, WSP(bf16_t, WS_VDT), WSP(bf16_t, WS_XN) + 512, WSP(unsigned long long, WS_MASK), WSP(float, TAB_LUT));
#endif
    }
    SEAM(PH_ATTN);
    if (IN(PH_MIXOUT)) { GemmP g{WSP(bf16_t, WS_XN), D, nullptr, D, D}; StaticSched S; S.init(MP / 256, 4, c.G, c.bid, WSP(bf16_t, WS_WMO), D, CAP_A); gemm_phase<false>(c, g, S, EpiResid{WSP(bf16_t, WS_H), WSP(bf16_t, WS_H), 0, WSP(float, WS_PART_A)}); }
    SEAM(PH_MIXOUT);
    if (IN(PH_NORM1)) { StaticSched S; S.init(MP / 256, 4, c.G, c.bid, nullptr, D, CAP_A); phase_norm_rows(c, WSP(bf16_t, WS_H), in[14], WSP(bf16_t, WS_XN), MP, S, WSP(float, WS_PART_A)); }
    SEAM(PH_NORM1);
    if (IN(PH_FFN1)) { GemmP g{WSP(bf16_t, WS_XN), D, nullptr, D, D}; StaticSched S; S.init(MP / 256, 2 * DFF / 256, c.G, c.bid, WSP(bf16_t, WS_W13), D, 0); gemm_phase<false>(c, g, S, EpiGlu{WSP(bf16_t, WS_HF), DFF});
        { int w, nw; const int a0 = idle_items(c.G, NWG_MIXIN, NE * MOE_IT13); if (idle_slot(c, NWG_FFN1, w, nw)) moe_conv_items<0>(c, in, ws, a0, a0 + idle_items(c.G, NWG_FFN1, NE * MOE_IT13 - a0), w, nw); } }
    SEAM(PH_FFN1);
    if (IN(PH_FFN2)) { GemmP g{WSP(bf16_t, WS_HF), DFF, nullptr, DFF, DFF}; StaticSched S; S.init(MP / 256, 4, c.G, c.bid, WSP(bf16_t, WS_W2), DFF, CAP_F); gemm_phase<false>(c, g, S, EpiResid{WSP(bf16_t, WS_H), WSP(bf16_t, WS_H), 0, WSP(float, WS_PART_F)}); }
    SEAM(PH_FFN2);
    if (IN(PH_NORM2)) { StaticSched S; S.init(MP / 256, 4, c.G, c.bid, nullptr, DFF, CAP_F); phase_norm_rows(c, WSP(bf16_t, WS_H), in[18], WSP(bf16_t, WS_XN), MP, S, WSP(float, WS_PART_F)); }
    SEAM(PH_NORM2);
    if (IN(PH_WIN)) { GemmP g{WSP(bf16_t, WS_XN), D, nullptr, D, D}; StaticSched S; S.init(MP / 256, 12, c.G, c.bid, WSP(bf16_t, WS_WIN), D, 0); gemm_phase<false>(c, g, S, EpiConvIn{WSP(bf16_t, WS_Z)});
        { int w, nw; if (idle_slot(c, NWG_WIN, w, nw)) moe_conv_items<1>(c, in, ws, 0, idle_items(c.G, NWG_WIN, NE * MOE_IT2), w, nw); } }
    SEAM(PH_WIN);
    if (IN(PH_CONV)) phase_conv(c, WSP(bf16_t, WS_Z), in[20], WSP(bf16_t, WS_XN));
    SEAM(PH_CONV);
    if (IN(PH_WOUT)) { GemmP g{WSP(bf16_t, WS_XN), D, nullptr, D, D}; StaticSched S; S.init(MR / 256, 4, c.G, c.bid, WSP(bf16_t, WS_WOUT), D, 0); gemm_phase<false>(c, g, S, EpiResid{WSP(bf16_t, WS_H), WSP(bf16_t, WS_H3B), 1, nullptr}); }
    SEAM(PH_WOUT);
    if (IN(PH_ROUTE)) {
        { const int a0 = idle_items(c.G, NWG_MIXIN, NE * MOE_IT13), d13 = a0 + idle_items(c.G, NWG_FFN1, NE * MOE_IT13 - a0), d2 = idle_items(c.G, NWG_WIN, NE * MOE_IT2);
          const int r13 = NE * MOE_IT13 - d13;
          moe_conv_items<0>(c, in, ws, d13, NE * MOE_IT13, c.gw, c.ngw);
          int w2 = (c.gw - r13 % c.ngw) % c.ngw; if (w2 < 0) w2 += c.ngw;
          moe_conv_items<1>(c, in, ws, d2, NE * MOE_IT2, w2, c.ngw); }
        { int* rowtok = WSP(int, TAB_ROWTOK); for (int i = c.bid * 512 + c.tid; i < 2 * MOE_ROWS; i += c.G * 512) rowtok[i] = -1; }
        phase_route(c, WSP(bf16_t, WS_H3B), in[22], in[23], WSP(unsigned char, WS_XN2), CNT, WSP(int, TAB_ASG), WSP(float, TAB_GATE));
    }
    SEAM(PH_ROUTE);
    if (IN(PH_SCATTER)) phase_scatter(c, CNT, WSP(int, TAB_ASG), WSP(float, TAB_GATE), WSP(int, TAB_ROWTOK), WSP(float, TAB_ROWGATE));
    SEAM(PH_SCATTER);
#pragma unroll
    for (int s = 0; s < 2; ++s) {
        if (IN(PH_MOE1A + 2 * s)) {
            if (s == 1) { MoeSched<4> S2; S2.init(CNT, c.G, c.bid, nullptr, 0, DFF / 2, CAP_M);
                phase_moe_fix<4, 0>(c, S2, WSP(int, TAB_ROWTOK), WSP(float, TAB_ROWGATE), WSP(float, WS_PART_M), args.out, 1.f / (F8_SH * F8_SW2), WSP(bf16_t, WS_PARTA), WSP(bf16_t, WS_H3B)); }
            GemmP g{WSP(bf16_t, WS_XN2), D / 2, WSP(int, TAB_ROWTOK) + s * MOE_ROWS, D / 2, D / 2}; MoeSched<2 * DFF / 256> S; S.init(CNT + 8 * s, c.G, c.bid, WSP(bf16_t, WS_MW13), (size_t)DFF * D, D / 2, 0);
            gemm_phase<true, true>(c, g, S, EpiGlu8{WSP(unsigned char, WS_HM), DFF}); }
        SEAM(PH_MOE1A + 2 * s);
        if (IN(PH_MOE2A + 2 * s)) { GemmP g{WSP(bf16_t, WS_HM), DFF / 2, nullptr, DFF / 2, DFF / 2}; MoeSched<4> S; S.init(CNT + 8 * s, c.G, c.bid, WSP(bf16_t, WS_MW2), (size_t)D * DFF / 2, DFF / 2, CAP_M);
            if (s == 0) gemm_phase<false, true>(c, g, S, EpiMoe2<0>{WSP(int, TAB_ROWTOK), WSP(float, TAB_ROWGATE), args.out, WSP(float, WS_PART_M), 1.f / (F8_SH * F8_SW2), WSP(bf16_t, WS_PARTA), WSP(bf16_t, WS_H3B)});
            else gemm_phase<false, true>(c, g, S, EpiMoe2<1>{WSP(int, TAB_ROWTOK) + MOE_ROWS, WSP(float, TAB_ROWGATE) + MOE_ROWS, args.out, WSP(float, WS_PART_M), 1.f / (F8_SH * F8_SW2), WSP(bf16_t, WS_PARTA), WSP(bf16_t, WS_H3B)}); }
        SEAM(PH_MOE2A + 2 * s);
    }
    if (IN(PH_FIX)) { MoeSched<4> S2; S2.init(CNT + 8, c.G, c.bid, nullptr, 0, DFF / 2, CAP_M);
        phase_moe_fix<4, 1>(c, S2, WSP(int, TAB_ROWTOK) + MOE_ROWS, WSP(float, TAB_ROWGATE) + MOE_ROWS, WSP(float, WS_PART_M), args.out, 1.f / (F8_SH * F8_SW2), WSP(bf16_t, WS_PARTA), WSP(bf16_t, WS_H3B)); }
}

extern "C" void kernel_launch(void* const* d_in, const int* in_sizes, int n_in, void* d_out, int out_size, void* d_ws, size_t ws_size, hipStream_t stream) {
    static int grid = 0;
    if (grid == 0) {
        if (n_in != 27 || out_size != MR * D || ws_size < WS_END) { fprintf(stderr, "kernel_launch: unexpected problem (n_in %d out %d ws %zu)\n", n_in, out_size, ws_size); grid = -1; return; }
        int dev = 0, cus = 0;
        if (hipGetDevice(&dev) != hipSuccess || hipDeviceGetAttribute(&cus, hipDeviceAttributeMultiprocessorCount, dev) != hipSuccess) { grid = -1; return; }
        if (hipFuncSetAttribute((const void*)mk_fwd, hipFuncAttributeMaxDynamicSharedMemorySize, LDS_BYTES) != hipSuccess) { grid = -1; return; }
        int per_cu = 0;
        if (hipOccupancyMaxActiveBlocksPerMultiprocessor(&per_cu, (const void*)mk_fwd, 512, LDS_BYTES) != hipSuccess || per_cu < 1) { fprintf(stderr, "kernel_launch: occupancy query says %d\n", per_cu); }
        (void)hipGetLastError();
        grid = cus;
    }
    if (grid < 0) return;
    (void)hipMemsetAsync((char*)d_ws + WS_CTL, 0, CTL_ZERO_BYTES, stream);
    Args a{};
    for (int i = 0; i < 27; ++i) a.in[i] = (const float*)d_in[i];
    a.out = (float*)d_out; a.ws = (unsigned char*)d_ws;
#if MK_ONE_LAUNCH
    a.ph_lo = 0; a.ph_hi = NPH;
    hipLaunchKernelGGL(mk_fwd, dim3(grid), dim3(512), LDS_BYTES, stream, a);
#else
    for (int p = 0; p < NPH; ++p) { a.ph_lo = p; a.ph_hi = p + 1; hipLaunchKernelGGL(mk_fwd, dim3(grid), dim3(512), LDS_BYTES, stream, a); }
#endif
}
```

```cpp
#include <hip/hip_runtime.h>
#include <cstdio>
#include <cstdint>

#ifndef NAIVE_ATTN
#define NAIVE_ATTN 0
#endif
#ifndef MK_ONE_LAUNCH
#define MK_ONE_LAUNCH 1
#endif

#define GAS __attribute__((address_space(1)))
#define LAS __attribute__((address_space(3)))
typedef unsigned short bf16_t;
typedef unsigned v4u __attribute__((ext_vector_type(4)));
typedef unsigned v2u __attribute__((ext_vector_type(2)));
typedef float f32x4 __attribute__((ext_vector_type(4)));
typedef GAS unsigned gu32;
#define RLX_AGENT __ATOMIC_RELAXED, __HIP_MEMORY_SCOPE_AGENT
#define DI __device__ __forceinline__

constexpr int NB = 8, SEQ = 4096, D = 1024, NMETA = 16, LTOT = SEQ + NMETA, LP = 4224, MP = NB * LP, MR = NB * SEQ;
constexpr int DFF = 3584, NE = 8;
constexpr int QR = 384, KVR = 256, MQK = 96, MLAW = 768;
constexpr int DW = 512, TOPK = 256;
constexpr int MIXIN = 2504, MIXN = 2560;
constexpr float EPS = 1e-6f;
constexpr float LOG2E = 1.4426950408889634f;
constexpr float MLA_QS = 0.10206207261596577f * LOG2E;
constexpr float DSA_QS = 0.125f * LOG2E;
constexpr int MOE_ROWS = 34816;

constexpr size_t MiB = 1u << 20;
constexpr size_t WS_CTL = 0, CTL_ZERO_BYTES = 64 * 1024;
constexpr size_t WS_TAB = 1 * MiB;
constexpr size_t TAB_LUT = WS_TAB;
constexpr size_t TAB_ROWTOK = WS_TAB + 64 * 1024;
constexpr size_t TAB_ROWGATE = TAB_ROWTOK + 2 * MOE_ROWS * 4;
constexpr size_t TAB_ASG = TAB_ROWGATE + 2 * MOE_ROWS * 4;
constexpr size_t TAB_GATE = TAB_ASG + 2 * MR * 4;
static_assert(TAB_GATE + 2 * MR * 4 <= 4 * MiB, "tables");
constexpr size_t WS_MASK = 480 * MiB;
constexpr size_t WS_PART_A = 240 * MiB, WS_PART_F = 471 * MiB, WS_PART_M = 4 * MiB;
constexpr int CAP_A = 128, CAP_F = 160, CAP_M = 152;
constexpr size_t WS_WMIX = 4 * MiB, WS_WUQ = 9 * MiB, WS_WUKV = 10 * MiB, WS_WMO = 11 * MiB, WS_W13 = 13 * MiB, WS_W2 = 27 * MiB, WS_WIN = 34 * MiB, WS_WOUT = 40 * MiB;
constexpr size_t WS_H = 42 * MiB;
constexpr size_t WS_XN = 174 * MiB;
constexpr size_t WS_LAT = 240 * MiB;
constexpr size_t WS_DQ = 290 * MiB, WS_DK = 323 * MiB, WS_DV = 356 * MiB;
constexpr size_t WS_IQ = 389 * MiB;
constexpr size_t WS_KR = 406 * MiB, WS_IK = 409 * MiB, WS_IW = 412 * MiB;
constexpr size_t WS_IWC = 412 * MiB;
constexpr size_t WS_IKC = 409 * MiB;
constexpr size_t WS_SSP = 406 * MiB;
constexpr size_t WS_VMT = 414 * MiB, WS_VDT = 447 * MiB;
constexpr size_t WS_HF = 240 * MiB;
constexpr size_t WS_Z = 240 * MiB;
constexpr size_t WS_MW13 = 108 * MiB, WS_MW2 = 438 * MiB;
constexpr size_t WS_XN2 = 405 * MiB;
constexpr size_t WS_PARTA = 42 * MiB;
constexpr size_t WS_H3B = 341 * MiB;
constexpr size_t WS_HM = 222 * MiB;
constexpr size_t WS_END = 512 * MiB;
static_assert(WS_H + (size_t)MP * D * 2 <= WS_MW13 && WS_PARTA + (size_t)MR * D * 2 <= WS_MW13 && WS_MW13 + (size_t)NE * 2 * DFF * D <= WS_XN && WS_HM + (size_t)MOE_ROWS * DFF <= WS_H3B && WS_H3B + (size_t)MR * D * 2 <= WS_XN2 && WS_XN2 + (size_t)MR * D <= WS_MW2 && WS_Z + (size_t)MP * 2048 * 2 <= WS_MW2 && WS_MW2 + (size_t)NE * DFF * D <= WS_END && WS_XN + (size_t)MP * D * 2 <= WS_H3B && WS_PART_M + (size_t)CAP_M * 262144 <= WS_PARTA, "ws map");
static_assert(WS_HF + (size_t)MP * DFF * 2 <= WS_END, "ws map");
constexpr size_t OUT_KV = 0, OUT_QM = 66 * MiB;

constexpr int CW_TMO = 0, CW_CNT = 64  , CW_SEL = 96  , CW_ATT = 112  , CW_BAR = 4096;

constexpr int WSCR = 18048;
constexpr int LDS_BYTES = 147456;
constexpr int MISC_OFF = LDS_BYTES - 128;
constexpr int RING_BYTES = 131072, GTAB_OFF = RING_BYTES, GTAB_SLOTS = 15;
static_assert(8 * WSCR <= MISC_OFF && GTAB_OFF + GTAB_SLOTS * 1024 <= MISC_OFF, "lds");

DI float bf2f(bf16_t x) { return __uint_as_float(((unsigned)x) << 16); }
DI unsigned f2bf(float f) { unsigned u = __float_as_uint(f); return (u + 0x7fffu + ((u >> 16) & 1u)) >> 16; }
typedef float f32x2_t __attribute__((ext_vector_type(2))); typedef __bf16 bf16x2_t __attribute__((ext_vector_type(2)));
DI unsigned pk2(float lo, float hi) { f32x2_t v = {lo, hi}; bf16x2_t b = __builtin_convertvector(v, bf16x2_t); return __builtin_bit_cast(unsigned, b); }
DI float lo2f(unsigned w) { return __uint_as_float(w << 16); }
DI float hi2f(unsigned w) { return __uint_as_float(w & 0xffff0000u); }
DI float wave_sum(float v) {
    v += __builtin_bit_cast(float, __builtin_amdgcn_update_dpp(0, __builtin_bit_cast(int, v), 0xB1, 0xf, 0xf, true));
    v += __builtin_bit_cast(float, __builtin_amdgcn_update_dpp(0, __builtin_bit_cast(int, v), 0x4E, 0xf, 0xf, true));
    v += __builtin_bit_cast(float, __builtin_amdgcn_update_dpp(0, __builtin_bit_cast(int, v), 0x141, 0xf, 0xf, true));
    v += __builtin_bit_cast(float, __builtin_amdgcn_update_dpp(0, __builtin_bit_cast(int, v), 0x140, 0xf, 0xf, true));
    const int iv = __builtin_bit_cast(int, v);
    return (__builtin_bit_cast(float, __builtin_amdgcn_readlane(iv, 0)) + __builtin_bit_cast(float, __builtin_amdgcn_readlane(iv, 16)))
         + (__builtin_bit_cast(float, __builtin_amdgcn_readlane(iv, 32)) + __builtin_bit_cast(float, __builtin_amdgcn_readlane(iv, 48)));
}
DI float wave_max(float v) {
#pragma unroll
    for (int o = 1; o < 64; o <<= 1) v = fmaxf(v, __shfl_xor(v, o));
    return v;
}
DI void unpack8(v4u w, float (&f)[8]) { f[0] = lo2f(w.x); f[1] = hi2f(w.x); f[2] = lo2f(w.y); f[3] = hi2f(w.y); f[4] = lo2f(w.z); f[5] = hi2f(w.z); f[6] = lo2f(w.w); f[7] = hi2f(w.w); }
DI v4u pack8(const float (&f)[8]) { v4u w; w.x = pk2(f[0], f[1]); w.y = pk2(f[2], f[3]); w.z = pk2(f[4], f[5]); w.w = pk2(f[6], f[7]); return w; }

#define XB_TMO      128
#define XB_XCNT(j)  (256  + 64 * (j))
#define XB_XSUB(j)  (1280 + 64 * (j))
#define XB_XGEN(j)  (2304 + 64 * (j))
#define XB_TOP      3328
#define XB_TOPGEN   3392
#define XCD_BAR_WORDS 3456
#define XB_SPIN_CAP (1u << 22)
DI unsigned xb_ld(unsigned* p)              { return __hip_atomic_load(p, __ATOMIC_RELAXED, __HIP_MEMORY_SCOPE_AGENT); }
DI unsigned xb_add(unsigned* p, unsigned v) { return __hip_atomic_fetch_add(p, v, __ATOMIC_RELAXED, __HIP_MEMORY_SCOPE_AGENT); }
DI unsigned xb_xcc_id() { return (unsigned)__builtin_amdgcn_s_getreg((3 << 11) | 20) & 0xFu; }
#define XB_SPIN(cond, bar) do { unsigned _sp = 0; while (cond) { __builtin_amdgcn_s_sleep(1); \
    if ((++_sp & 255u) == 0u) { if (xb_ld(&(bar)[XB_TMO])) break; if (_sp > XB_SPIN_CAP) { atomicAdd(&(bar)[XB_TMO], 1u); break; } } } } while (0)
struct XcdBarrier { unsigned* bar; unsigned x; volatile LAS unsigned* st; };
DI XcdBarrier xcd_barrier_post(unsigned* bar, volatile LAS unsigned* st) {
    XcdBarrier b; b.bar = bar; b.x = xb_xcc_id(); b.st = st;
    if (threadIdx.x == 0) (void)xb_add(&bar[XB_XCNT(b.x)], 1u);
    return b;
}
DI void xcd_barrier_complete(unsigned* bar, unsigned x, unsigned& nloc, unsigned& nx) {
    const unsigned G = gridDim.x * gridDim.y * gridDim.z;
    unsigned sum, cnt, mine, sp = 0u;
    for (;;) {
        sum = 0u; cnt = 0u; mine = 0u;
#pragma unroll
        for (unsigned j = 0; j < 16; ++j) { const unsigned c = xb_ld(&bar[XB_XCNT(j)]); sum += c; cnt += (c > 0u) ? 1u : 0u; mine = (j == x) ? c : mine; }
        if (sum == G) break;
        __builtin_amdgcn_s_sleep(1);
        if ((++sp & 255u) == 0u) { if (xb_ld(&bar[XB_TMO])) break; if (sp > XB_SPIN_CAP) { atomicAdd(&bar[XB_TMO], 1u); break; } }
    }
    nloc = mine > 0u ? mine : 1u; nx = cnt > 0u ? cnt : 1u;
}
DI void xcd_barrier(const XcdBarrier& b) {
    asm volatile("s_waitcnt vmcnt(0)" ::: "memory");
    __syncthreads();
    if (threadIdx.x == 0) {
        unsigned* bar = b.bar;
        __builtin_amdgcn_s_waitcnt(0);
        unsigned nloc = b.st[0], nx = b.st[1];
        if (nloc == 0u) { xcd_barrier_complete(bar, b.x, nloc, nx); b.st[0] = nloc; b.st[1] = nx; }
        const unsigned old = xb_add(&bar[XB_XSUB(b.x)], 1u);
        const unsigned gen = old / nloc;
        if (old + 1u == (gen + 1u) * nloc) {
            __builtin_amdgcn_fence(__ATOMIC_RELEASE, "agent");
            asm volatile("s_waitcnt vmcnt(0)" ::: "memory");
            const unsigned og = xb_add(&bar[XB_TOP], 1u);
            const unsigned tg = og / nx;
            if (og + 1u == (tg + 1u) * nx) xb_add(&bar[XB_TOPGEN], 1u);
            else XB_SPIN(xb_ld(&bar[XB_TOPGEN]) == tg, bar);
            __builtin_amdgcn_fence(__ATOMIC_ACQUIRE, "agent");
            xb_add(&bar[XB_XGEN(b.x)], 1u);
            asm volatile("s_waitcnt vmcnt(0)" ::: "memory");
        } else {
            XB_SPIN(xb_ld(&bar[XB_XGEN(b.x)]) == gen, bar);
            __builtin_amdgcn_fence(__ATOMIC_ACQUIRE, "agent");
            asm volatile("s_waitcnt vmcnt(0)" ::: "memory");
        }
    }
    __syncthreads();
}

struct Args { const float* in[27]; float* out; unsigned char* ws; int ph_lo, ph_hi; };
struct Ctx {
    int tid, lane, wave, gw, ngw, G, bid;
    unsigned char* lds;
    unsigned char* wscr;
};

struct Unit { int pm, pn; const bf16_t* Bt; int koff, nt, atomic; };
struct GemmP { const bf16_t* A; int lda; const int* arow; int ldb; int K; };

DI int pick_split(int tail, int cap, int k128) {
    const int cand[6] = {28, 14, 8, 7, 4, 2};
    int S = 1;
#pragma unroll
    for (int i = 5; i >= 0; --i) if (k128 % cand[i] == 0 && tail * cand[i] <= cap) S = cand[i];
    return S;
}
struct StaticSched {
    int nM, nN, nwg, G, c, full, S, ntf, nts; const bf16_t* Bt;
    DI void init(int nM_, int nN_, int G_, int c_, const bf16_t* Bt_, int K, int cap) {
        nM = nM_; nN = nN_; nwg = nM * nN; G = G_; c = c_; Bt = Bt_; ntf = K / 64; full = nwg; S = 1; nts = ntf;
        if (cap > 0) { full = (nwg / G) * G; const int tail = nwg - full; if (tail > 0) { S = pick_split(tail, cap < G ? cap : G, K / 128); nts = ntf / S; } if (S == 1) full = nwg; }
    }
    DI bool next(int i, Unit& u) const {
        const int L = i * G + c; int wgid;
        if (L < full) { wgid = L; u.koff = 0; u.nt = ntf; u.atomic = 0; }
        else { const int r = L - full; if (r >= (nwg - full) * S) return false; wgid = full + r / S; u.koff = (r % S) * nts * 64; u.nt = nts; u.atomic = r + 1; }
        { const int q = nwg / 8, r = nwg % 8, xcd = wgid % 8, off = wgid / 8; wgid = (xcd < r ? xcd * (q + 1) : r * (q + 1) + (xcd - r) * q) + off; }
        const int nig = 8 * nN, gid = wgid / nig, fm = gid * 8, gsz = (nM - fm) < 8 ? (nM - fm) : 8;
        u.pm = fm + ((wgid % nig) % gsz); u.pn = (wgid % nig) / gsz; u.Bt = Bt; return true;
    }
    DI int index_of(int pm, int pn) const {
        const int nig = 8 * nN, gid = pm / 8, fm = gid * 8, gsz = (nM - fm) < 8 ? (nM - fm) : 8;
        const int w = gid * nig + pn * gsz + (pm - fm);
        const int q = nwg / 8, r = nwg % 8; int xcd, off;
        if (w < r * (q + 1)) { xcd = w / (q + 1); off = w % (q + 1); } else { const int w2 = w - r * (q + 1); xcd = r + w2 / q; off = w2 % q; }
        return off * 8 + xcd;
    }
};
template <int NN>
struct MoeSched {
    int tiles[NE]; int nM, G, c, full, S, ntf, nts; const bf16_t* Bt; size_t estride;
    DI void init(const unsigned* cnt, int G_, int c_, const bf16_t* Bt_, size_t estride_, int K, int cap) {
        nM = 0;
#pragma unroll
        for (int e = 0; e < NE; ++e) { tiles[e] = __builtin_amdgcn_readfirstlane((int)((__hip_atomic_load(cnt + e, RLX_AGENT) + 255u) >> 8)); nM += tiles[e]; }
        G = G_; c = c_; Bt = Bt_; estride = estride_; ntf = K / 64; const int nwg = nM * NN; full = nwg; S = 1; nts = ntf;
        if (cap > 0) { full = (nwg / G) * G; const int tail = nwg - full; if (tail > 0) { S = pick_split(tail, cap < G ? cap : G, K / 128); nts = ntf / S; } if (S == 1) full = nwg; }
    }
    DI bool next(int i, Unit& u) const {
        const int L = i * G + c, nwg = nM * NN; int id;
        if (L < full) { id = L; u.koff = 0; u.nt = ntf; u.atomic = 0; }
        else { const int r = L - full; if (r >= (nwg - full) * S) return false; id = full + r / S; u.koff = (r % S) * nts * 64; u.nt = nts; u.atomic = r + 1; }
        u.pm = id / NN; u.pn = id % NN;
        int e = 0, acc = 0;
#pragma unroll
        for (int k = 0; k < NE; ++k) { acc += tiles[k]; if (u.pm >= acc) e = k + 1; }
        if (e > NE - 1) e = NE - 1;
        u.Bt = Bt + (size_t)e * estride; return true;
    }
};

DI void st8bf(bf16_t* p, const float (&v)[8]) { *(v4u*)p = pack8(v); }
struct EpiRoute {
    unsigned char* ws; const float* g_dq; const float* g_dk;
    DI void elem8(int row, int pn, int c0, const float (&v0)[8], const float (&v1)[8], int) const {
        if (pn >= 3 && pn < 7) {
            const int isk = pn >= 5, wc = c0 >> 5, fq8 = c0 & 31, head = ((pn - 3) & 1) * 4 + wc;
            float ss = 0.f;
#pragma unroll
            for (int j = 0; j < 8; ++j) ss += v0[j] * v0[j] + v1[j] * v1[j];
            ss += __shfl_xor(ss, 16); ss += __shfl_xor(ss, 32);
            const float rstd = 1.0f / sqrtf(ss * (1.f / 64.f) + EPS) * (isk ? 1.f : DSA_QS);
            const float* g = (isk ? g_dk : g_dq) + fq8;
            float a[8], bq[8];
#pragma unroll
            for (int j = 0; j < 8; ++j) { a[j] = v0[j] * rstd * g[j]; bq[j] = v1[j] * rstd * g[32 + j]; }
            bf16_t* p = (bf16_t*)(ws + (isk ? WS_DK : WS_DQ)) + (size_t)row * 512 + head * 64 + fq8; st8bf(p, a); st8bf(p + 32, bq);
            return;
        }
        size_t off; int ld, col;
        if (pn < 3) { off = WS_LAT; ld = 768; col = pn * 256;
            float ss = 0.f;
#pragma unroll
            for (int j = 0; j < 8; ++j) ss += v0[j] * v0[j] + (pn < 2 ? v1[j] * v1[j] : 0.f);
            ss += __shfl_xor(ss, 16); ss += __shfl_xor(ss, 32);
            if ((c0 & 31) == 0) ((float*)(ws + WS_SSP))[(size_t)row * 12 + pn * 4 + (c0 >> 5)] = ss; }
        else if (pn < 9) { off = WS_DV; ld = 512; col = (pn - 7) * 256; }
        else { off = WS_IQ; ld = 256; col = 0; }
        bf16_t* p = (bf16_t*)(ws + off) + (size_t)row * ld + col + c0; st8bf(p, v0); st8bf(p + 128, v1);
        if (pn == 2 && c0 == 64) st8bf((bf16_t*)(ws + WS_IWC) + (size_t)row * 8, v1);
        if (pn == 2 && (c0 >> 5) == 1) { const int bb = row / LP, tt = row - bb * LP; st8bf((bf16_t*)(ws + WS_IKC) + ((size_t)(bb * 4 + ((c0 >> 3) & 3)) * LP + tt) * 8, v1); }
    }
};
struct EpiUp {
    bf16_t* O; int ld; const float* ssp; int isq;
    DI void elem8(int row, int pn, int c0, const float (&v0)[8], const float (&v1)[8], int) const {
        const f32x4* sp = (const f32x4*)(ssp + (size_t)row * 12);
        float rstd;
        if (isq) { const f32x4 a = sp[1], b = sp[2]; rstd = 1.0f / sqrtf((((a.x + a.y) + (a.z + a.w)) + ((b.x + b.y) + (b.z + b.w))) * (1.f / QR) + EPS); }
        else { const f32x4 a = sp[0]; rstd = 1.0f / sqrtf(((a.x + a.y) + (a.z + a.w)) * (1.f / KVR) + EPS); }
        float a[8], bq[8];
#pragma unroll
        for (int j = 0; j < 8; ++j) { a[j] = v0[j] * rstd; bq[j] = v1[j] * rstd; }
        bf16_t* p = O + (size_t)row * ld + pn * 256 + c0; st8bf(p, a); st8bf(p + 128, bq);
    }
};
struct EpiBf16 {
    bf16_t* O; int ld;
    DI void elem8(int row, int pn, int c0, const float (&v0)[8], const float (&v1)[8], int atomic) const { bf16_t* p = O + (size_t)row * ld + pn * 256 + c0; st8bf(p, v0); st8bf(p + 128, v1); }
};
DI unsigned pk4f8(float a, float b, float c2, float d) {
    a = __builtin_amdgcn_fmed3f(a, -448.f, 448.f); b = __builtin_amdgcn_fmed3f(b, -448.f, 448.f); c2 = __builtin_amdgcn_fmed3f(c2, -448.f, 448.f); d = __builtin_amdgcn_fmed3f(d, -448.f, 448.f);
    int w = 0; w = __builtin_amdgcn_cvt_pk_fp8_f32(a, b, w, false); w = __builtin_amdgcn_cvt_pk_fp8_f32(c2, d, w, true); return (unsigned)w;
}
constexpr float F8_SX = 4.f, F8_SW1 = 64.f, F8_SH = 8.f, F8_SW2 = 128.f;
struct EpiGlu8 {
    unsigned char* H; int ld;
    DI void elem8(int row, int pn, int c0, const float (&v0)[8], const float (&v1)[8], int atomic) const {
        constexpr float inv = 1.f / (F8_SX * F8_SW1);
        float o[8];
#pragma unroll
        for (int j = 0; j < 8; ++j) { const float x = v0[j] * inv; o[j] = x * __builtin_amdgcn_rcpf(1.f + __builtin_amdgcn_exp2f(-LOG2E * x)) * (v1[j] * (inv * F8_SH)); }
        v2u w; w.x = pk4f8(o[0], o[1], o[2], o[3]); w.y = pk4f8(o[4], o[5], o[6], o[7]);
        *(v2u*)(H + (size_t)row * ld + pn * 128 + c0) = w;
    }
};
struct EpiConvIn {
    bf16_t* Z2;
    DI void elem8(int row, int pn, int c0, const float (&v0)[8], const float (&v1)[8], int atomic) const {
        bf16_t* p = Z2 + (size_t)row * 2048;
        if (pn < 8) { float o[8];
#pragma unroll
            for (int j = 0; j < 8; ++j) o[j] = v0[j] * v1[j];
            st8bf(p + pn * 128 + c0, o); }
        else { p += 1024 + (pn - 8) * 256 + c0; st8bf(p, v0); st8bf(p + 128, v1); }
    }
};
struct EpiGlu {
    bf16_t* H; int ld;
    DI void elem8(int row, int pn, int c0, const float (&v0)[8], const float (&v1)[8], int atomic) const {
        float o[8];
#pragma unroll
        for (int j = 0; j < 8; ++j) { const float x = v0[j]; o[j] = x * __builtin_amdgcn_rcpf(1.f + __builtin_amdgcn_exp2f(-LOG2E * x)) * v1[j]; }
        st8bf(H + (size_t)row * ld + pn * 128 + c0, o);
    }
};
DI void st8f(float* p, const float (&v)[8]) { *(f32x4*)p = (f32x4){v[0], v[1], v[2], v[3]}; *(f32x4*)(p + 4) = (f32x4){v[4], v[5], v[6], v[7]}; }
DI void part_store(float* part, int slab, int row, int c0, const float (&v0)[8], const float (&v1)[8]) {
    const __amdgpu_buffer_rsrc_t rsrc = __builtin_amdgcn_make_buffer_rsrc((void*)part, 0, 0x40000000, 0x00020000);
    const unsigned off = (unsigned)slab * 262144u + (unsigned)(((row & 255) * 256 + c0) * 4);
    __builtin_amdgcn_raw_buffer_store_b128((v4u){__float_as_uint(v0[0]), __float_as_uint(v0[1]), __float_as_uint(v0[2]), __float_as_uint(v0[3])}, rsrc, off, 0, 0);
    __builtin_amdgcn_raw_buffer_store_b128((v4u){__float_as_uint(v0[4]), __float_as_uint(v0[5]), __float_as_uint(v0[6]), __float_as_uint(v0[7])}, rsrc, off + 16u, 0, 0);
    __builtin_amdgcn_raw_buffer_store_b128((v4u){__float_as_uint(v1[0]), __float_as_uint(v1[1]), __float_as_uint(v1[2]), __float_as_uint(v1[3])}, rsrc, off + 512u, 0, 0);
    __builtin_amdgcn_raw_buffer_store_b128((v4u){__float_as_uint(v1[4]), __float_as_uint(v1[5]), __float_as_uint(v1[6]), __float_as_uint(v1[7])}, rsrc, off + 528u, 0, 0);
}
struct EpiResid {
    const bf16_t* base; bf16_t* out; int real; float* part;
    DI void elem8(int row, int pn, int c0, const float (&v0)[8], const float (&v1)[8], int atomic) const {
        if (atomic) { part_store(part, atomic - 1, row, c0, v0, v1); return; }
        const int brow = real ? ((row >> 12) * LP + NMETA + (row & 4095)) : row;
        const bf16_t* bp = base + (size_t)brow * D + pn * 256 + c0;
        float a[8], b[8]; unpack8(*(const v4u*)bp, a); unpack8(*(const v4u*)(bp + 128), b);
#pragma unroll
        for (int j = 0; j < 8; ++j) { a[j] += v0[j]; b[j] += v1[j]; }
        bf16_t* op = out + (size_t)row * D + pn * 256 + c0; st8bf(op, a); st8bf(op + 128, b);
    }
};
template <int SLOT>
struct EpiMoe2 {
    const int* rowtok; const float* rowgate; float* out; float* part; float sc; bf16_t* parta; const bf16_t* h3;
    DI void elem8(int row, int pn, int c0, const float (&v0)[8], const float (&v1)[8], int atomic) const {
        if (atomic) { part_store(part, atomic - 1, row, c0, v0, v1); return; }
        const int tok = rowtok[row]; if (tok < 0) return; const float g = rowgate[row] * sc;
        const __amdgpu_buffer_rsrc_t rp = __builtin_amdgcn_make_buffer_rsrc((void*)parta, 0, 0x04000000, 0x00020000);
        const unsigned offb = (unsigned)tok * (unsigned)(D * 2) + (unsigned)((pn * 256 + c0) * 2);
        float a[8], b[8];
#pragma unroll
        for (int j = 0; j < 8; ++j) { a[j] = v0[j] * g; b[j] = v1[j] * g; }
        if constexpr (SLOT == 0) {
            __builtin_amdgcn_raw_buffer_store_b128(pack8(a), rp, offb, 0, 0); __builtin_amdgcn_raw_buffer_store_b128(pack8(b), rp, offb + 256u, 0, 0);
        } else {
            const __amdgpu_buffer_rsrc_t rh = __builtin_amdgcn_make_buffer_rsrc((void*)h3, 0, 0x04000000, 0x00020000);
            const __amdgpu_buffer_rsrc_t ro = __builtin_amdgcn_make_buffer_rsrc((void*)out, 0, 0x08000000, 0x00020000);
            const v4u pa = __builtin_amdgcn_raw_buffer_load_b128(rp, offb, 0, 0), pb = __builtin_amdgcn_raw_buffer_load_b128(rp, offb + 256u, 0, 0);
            const v4u ha = __builtin_amdgcn_raw_buffer_load_b128(rh, offb, 0, 0), hb = __builtin_amdgcn_raw_buffer_load_b128(rh, offb + 256u, 0, 0);
            float t[8], u[8];
            unpack8(pa, t); unpack8(ha, u);
#pragma unroll
            for (int j = 0; j < 8; ++j) a[j] += t[j] + u[j];
            unpack8(pb, t); unpack8(hb, u);
#pragma unroll
            for (int j = 0; j < 8; ++j) b[j] += t[j] + u[j];
            const unsigned off = 2u * offb;
#define MOE2_V4(X_, j0) (v4u){__float_as_uint(X_[j0]), __float_as_uint(X_[j0 + 1]), __float_as_uint(X_[j0 + 2]), __float_as_uint(X_[j0 + 3])}
            __builtin_amdgcn_raw_buffer_store_b128(MOE2_V4(a, 0), ro, off, 0, 0); __builtin_amdgcn_raw_buffer_store_b128(MOE2_V4(a, 4), ro, off + 16u, 0, 0);
            __builtin_amdgcn_raw_buffer_store_b128(MOE2_V4(b, 0), ro, off + 512u, 0, 0); __builtin_amdgcn_raw_buffer_store_b128(MOE2_V4(b, 4), ro, off + 528u, 0, 0);
#undef MOE2_V4
        }
    }
};

template <class Epi, class Sched>
DI void gemm_phase_naive(const Ctx& c, const GemmP g, const Sched& S, const Epi& E) {
    float* As = (float*)c.lds;
    float* Bs = (float*)(c.lds + 32 * 132 * 4);
    const int tid = c.tid, ty = tid >> 4, tx = tid & 15;
    Unit u;
    for (int i = 0; S.next(i, u); ++i) {
        for (int half = 0; half < 2; ++half) {
            float acc0[4][8], acc1[4][8];
#pragma unroll
            for (int a = 0; a < 4; ++a)
#pragma unroll
                for (int j = 0; j < 8; ++j) { acc0[a][j] = 0.f; acc1[a][j] = 0.f; }
            const int rbase = u.pm * 256 + half * 128;
            const int ar = tid >> 2, ak = (tid & 3) * 8;
            int arow_g = g.arow ? g.arow[rbase + ar] : (rbase + ar); if (arow_g < 0) arow_g = 0;
            const bf16_t* ap = g.A + (size_t)arow_g * g.lda + ak + u.koff;
            const int bn = tid >> 1, bk = (tid & 1) * 16;
            const bf16_t* bp = u.Bt + (size_t)(u.pn * 256 + bn) * g.ldb + bk + u.koff;
            for (int k0 = 0; k0 < u.nt * 64; k0 += 32) {
                { float f[8]; unpack8(*(const v4u*)(ap + k0), f);
#pragma unroll
                  for (int j = 0; j < 8; ++j) As[(ak + j) * 132 + ar] = f[j]; }
                { float f[8]; unpack8(*(const v4u*)(bp + k0), f);
#pragma unroll
                  for (int j = 0; j < 8; ++j) Bs[(bk + j) * 260 + bn] = f[j];
                  unpack8(*(const v4u*)(bp + k0 + 8), f);
#pragma unroll
                  for (int j = 0; j < 8; ++j) Bs[(bk + 8 + j) * 260 + bn] = f[j]; }
                __syncthreads();
#pragma unroll 4
                for (int k = 0; k < 32; ++k) {
                    const f32x4 a = *(const f32x4*)(As + k * 132 + ty * 4);
                    const f32x4 p0 = *(const f32x4*)(Bs + k * 260 + tx * 8), p1 = *(const f32x4*)(Bs + k * 260 + tx * 8 + 4);
                    const f32x4 q0 = *(const f32x4*)(Bs + k * 260 + 128 + tx * 8), q1 = *(const f32x4*)(Bs + k * 260 + 128 + tx * 8 + 4);
                    const float av[4] = {a.x, a.y, a.z, a.w};
                    const float b0[8] = {p0.x, p0.y, p0.z, p0.w, p1.x, p1.y, p1.z, p1.w};
                    const float b1[8] = {q0.x, q0.y, q0.z, q0.w, q1.x, q1.y, q1.z, q1.w};
#pragma unroll
                    for (int r = 0; r < 4; ++r)
#pragma unroll
                        for (int j = 0; j < 8; ++j) { acc0[r][j] += av[r] * b0[j]; acc1[r][j] += av[r] * b1[j]; }
                }
                __syncthreads();
            }
#pragma unroll
            for (int r = 0; r < 4; ++r) E.elem8(rbase + ty * 4 + r, u.pn, tx * 8, acc0[r], acc1[r], u.atomic);
        }
    }
}

namespace pg8 {
typedef short bf16x8 __attribute__((ext_vector_type(8)));
constexpr int BK = 64, HTB = 128 * BK * 2;
DI int lds_byte(int r, int c) { const int st = (r >> 4) * 2 + (c >> 5), rr = r & 15, cc = c & 31, ob = rr * 64 + cc * 2; return st * 1024 + (ob ^ (((ob >> 9) & 1) << 5)); }
DI void stage_rc(int b, int& R, int& C) { const int st = b / 1024, sb = b % 1024, swz = sb ^ (((sb >> 9) & 1) << 5); R = (st >> 1) * 16 + swz / 64; C = (st & 1) * 32 + (swz % 64) / 2; }
DI int perm32(int rho) { const int n = rho >> 4, i = rho & 15; return 8 * (i >> 2) + 4 * n + (i & 3); }

typedef short s16x16 __attribute__((ext_vector_type(16))); typedef int i32x8 __attribute__((ext_vector_type(8)));
template <bool GATHER, bool F8, class Epi, class Sched>
DI void gemm_phase(LAS unsigned char* lds, const GemmP g, const Sched& S, const Epi& E) {
    int tid_ = threadIdx.x; asm volatile("" : "+v"(tid_));
    const int tid = tid_, wid = __builtin_amdgcn_readfirstlane(tid >> 6), lane = tid & 63, wr = wid >> 2, wc = wid & 3, fr = lane & 15, fq = lane >> 4;
    int R0, C0; stage_rc(tid * 16, R0, C0);
    const unsigned voffB0 = (unsigned)(((R0 & ~31) + perm32(R0 & 31)) * g.ldb + C0) * 2u;
    const unsigned voffA0 = (unsigned)(R0 * g.lda + C0) * 2u;
    const size_t kstep = (size_t)(BK * 2);
    const size_t hstepB = (size_t)128 * g.ldb * 2, pstepB = (size_t)64 * g.ldb * 2;
    const size_t hstepA = (size_t)128 * g.lda * 2, pstepA = (size_t)64 * g.lda * 2;
    const unsigned ldsw = (unsigned)wid * 1024u;
    const int aoff = lds_byte(wr * 64 + fr, fq * 8), boff = lds_byte(wc * 32 + fr, fq * 8);
    LAS unsigned* gtab = (LAS unsigned*)(lds + GTAB_OFF);
    if constexpr (GATHER) {
        Unit u;
#pragma nounroll
        for (int i = 0; i < GTAB_SLOTS && S.next(i, u); ++i)
            if (tid < 256) { int r = g.arow[u.pm * 256 + tid]; if (r < 0) r = 0; gtab[i * 256 + tid] = (unsigned)r * (unsigned)(g.lda * 2); }
        asm volatile("s_waitcnt vmcnt(0) lgkmcnt(0)" ::: "memory"); __builtin_amdgcn_s_barrier(); asm volatile("" ::: "memory");
    }
#define PG8_SA(b, h) (((b) * 2 + (h)) * HTB)
#define PG8_SB(b, h) ((4 + (b) * 2 + (h)) * HTB)
#define PG8_GLDS(gp, bufoff, i) __builtin_amdgcn_global_load_lds((const unsigned*)(gp), (LAS unsigned*)(lds + (bufoff) + ldsw + (i) * 8192), 16, 0, 0)
#define PG8_STAGE_B(bufoff, gbase) do { PG8_GLDS((const char*)(gbase) + voffB0, bufoff, 0); PG8_GLDS((const char*)(gbase) + pstepB + voffB0, bufoff, 1); } while (0)
#define PG8_STAGE_A(bufoff, ubase, kbase, h, ao) do { if constexpr (GATHER) { PG8_GLDS((const char*)(kbase) + (ao)[h][0], bufoff, 0); PG8_GLDS((const char*)(kbase) + (ao)[h][1], bufoff, 1); } \
        else { PG8_GLDS((const char*)(ubase) + (h) * hstepA + voffA0, bufoff, 0); PG8_GLDS((const char*)(ubase) + (h) * hstepA + pstepA + voffA0, bufoff, 1); } } while (0)
#define PG8_LDA(dst, b, h) do { _Pragma("unroll") for (int m = 0; m < 4; ++m) _Pragma("unroll") for (int k = 0; k < 2; ++k) dst[m][k] = *(const LAS bf16x8*)(lds + PG8_SA(b, h) + aoff + m * 2048 + k * 1024); } while (0)
#define PG8_LDB(dst, b, h) do { _Pragma("unroll") for (int n = 0; n < 2; ++n) _Pragma("unroll") for (int k = 0; k < 2; ++k) dst[n][k] = *(const LAS bf16x8*)(lds + PG8_SB(b, h) + boff + n * 2048 + k * 1024); } while (0)
#define PG8_CAT(x) __builtin_bit_cast(i32x8, __builtin_shufflevector((x)[0], (x)[1], 0, 1, 2, 3, 4, 5, 6, 7, 8, 9, 10, 11, 12, 13, 14, 15))
#define PG8_MMA(ai, bj, At, Bt) do { __builtin_amdgcn_s_setprio(1); _Pragma("unroll") for (int m = 0; m < 4; ++m) _Pragma("unroll") for (int n = 0; n < 2; ++n) { \
        if constexpr (F8) acc[ai][bj][m][n] = __builtin_amdgcn_mfma_scale_f32_16x16x128_f8f6f4(PG8_CAT(Bt[n]), PG8_CAT(At[m]), acc[ai][bj][m][n], 0, 0, 0, 0, 0, 0); \
        else { _Pragma("unroll") for (int k = 0; k < 2; ++k) acc[ai][bj][m][n] = __builtin_amdgcn_mfma_f32_16x16x32_bf16(Bt[n][k], At[m][k], acc[ai][bj][m][n], 0, 0, 0); } } __builtin_amdgcn_s_setprio(0); } while (0)
#define PG8_WAIT_V(n) asm volatile("s_waitcnt vmcnt(" #n ")" ::: "memory")
#define PG8_WAIT_L(n) asm volatile("s_waitcnt lgkmcnt(" #n ")" ::: "memory")
#define PG8_BAR __builtin_amdgcn_s_barrier()
#define PG8_SCHED __builtin_amdgcn_sched_barrier(0)
#define PG8_GOFFS(dst, slot, ko) do { _Pragma("unroll") for (int _h = 0; _h < 2; ++_h) _Pragma("unroll") for (int _i = 0; _i < 2; ++_i) \
        dst[_h][_i] = gtab[(slot) * 256 + _h * 128 + _i * 64 + R0] + (unsigned)(C0 * 2) + (unsigned)((ko) * 2); } while (0)
    Unit cur, nxt; int ui = 0;
    if (!S.next(0, cur)) return;
    f32x4 acc[2][2][4][2];
#pragma unroll
    for (int a = 0; a < 2; ++a)
#pragma unroll
        for (int b = 0; b < 2; ++b)
#pragma unroll
            for (int m = 0; m < 4; ++m)
#pragma unroll
                for (int n = 0; n < 2; ++n) acc[a][b][m][n] = (f32x4){0.f, 0.f, 0.f, 0.f};
    bf16x8 At[4][2], B0[2][2], B1[2][2];
    unsigned aoC[2][2] = {{0u, 0u}, {0u, 0u}};
    if constexpr (GATHER) { PG8_GOFFS(aoC, 0, cur.koff); }
    const char* Ab = (const char*)g.A;
    const char* cA = (const char*)g.A + ((size_t)cur.pm * 256 * g.lda + cur.koff) * 2;
    const char* cB = (const char*)cur.Bt + ((size_t)cur.pn * 256 * g.ldb + cur.koff) * 2;
    PG8_STAGE_B(PG8_SB(0, 0), cB); PG8_STAGE_B(PG8_SB(0, 1), cB + hstepB); PG8_STAGE_A(PG8_SA(0, 0), cA, Ab, 0, aoC); PG8_STAGE_A(PG8_SA(0, 1), cA, Ab, 1, aoC);
    if (wr == 1) PG8_BAR;
    PG8_WAIT_V(2); PG8_BAR;
    PG8_STAGE_B(PG8_SB(1, 0), cB + kstep); PG8_STAGE_A(PG8_SA(1, 0), cA + kstep, Ab + kstep, 0, aoC); PG8_STAGE_B(PG8_SB(1, 1), cB + hstepB + kstep);
    PG8_WAIT_V(6); PG8_BAR;
    for (;;) {
        const bool has_next = S.next(ui + 1, nxt);
        const char* nA = has_next ? (const char*)g.A + ((size_t)nxt.pm * 256 * g.lda + nxt.koff) * 2 : cA;
        const char* nB = has_next ? (const char*)nxt.Bt + ((size_t)nxt.pn * 256 * g.ldb + nxt.koff) * 2 : cB;
        const int nt = cur.nt;
        for (int t = 0; t < nt; t += 2) {
            const bool last = (t == nt - 2);
            const char* a1 = cA + (size_t)(t + 1) * kstep; const char* g1 = Ab + (size_t)(t + 1) * kstep;
            const char* a2 = last ? nA : cA + (size_t)(t + 2) * kstep; const char* g2 = last ? Ab : Ab + (size_t)(t + 2) * kstep;
            const char* b2 = last ? nB : cB + (size_t)(t + 2) * kstep;
            const char* a3 = a2 + kstep; const char* g3 = g2 + kstep; const char* b3 = b2 + kstep;
            asm volatile("" : "+s"(a1), "+s"(a2), "+s"(a3), "+s"(b2), "+s"(b3));
            PG8_LDB(B0, 0, 0); PG8_LDB(B1, 0, 1); PG8_SCHED; PG8_LDA(At, 0, 0); PG8_STAGE_A(PG8_SA(1, 1), a1, g1, 1, aoC);
            if constexpr (GATHER) { if (last && has_next) { PG8_GOFFS(aoC, ui + 1, nxt.koff); } }
            PG8_WAIT_V(8); PG8_WAIT_L(0); PG8_BAR; PG8_MMA(0, 0, At, B0); PG8_MMA(0, 1, At, B1); PG8_BAR; PG8_SCHED;
            PG8_LDA(At, 0, 1); PG8_STAGE_B(PG8_SB(0, 0), b2); PG8_STAGE_B(PG8_SB(0, 1), b2 + hstepB); PG8_STAGE_A(PG8_SA(0, 0), a2, g2, 0, aoC);
            PG8_WAIT_V(8); PG8_WAIT_L(0); PG8_BAR; PG8_MMA(1, 0, At, B0); PG8_MMA(1, 1, At, B1); PG8_BAR; PG8_SCHED;
            PG8_LDB(B0, 1, 0); PG8_LDB(B1, 1, 1); PG8_SCHED; PG8_LDA(At, 1, 0); PG8_STAGE_A(PG8_SA(0, 1), a2, g2, 1, aoC);
            PG8_WAIT_V(8); PG8_WAIT_L(0); PG8_BAR; PG8_MMA(0, 0, At, B0); PG8_MMA(0, 1, At, B1); PG8_BAR; PG8_SCHED;
            PG8_LDA(At, 1, 1); PG8_STAGE_B(PG8_SB(1, 0), b3); PG8_STAGE_B(PG8_SB(1, 1), b3 + hstepB); PG8_STAGE_A(PG8_SA(1, 0), a3, g3, 0, aoC);
            PG8_WAIT_V(8); PG8_WAIT_L(0); PG8_BAR; PG8_MMA(1, 0, At, B0); PG8_MMA(1, 1, At, B1); PG8_BAR; PG8_SCHED;
        }
        if (wr == 0) PG8_BAR;
        int te_ = threadIdx.x; asm volatile("" : "+v"(te_));
        const int fr = te_ & 15, fq = (te_ >> 4) & 3;
#pragma unroll
        for (int ai = 0; ai < 2; ++ai)
#pragma unroll
            for (int m = 0; m < 4; ++m) {
                float v0[8], v1[8];
#pragma unroll
                for (int n = 0; n < 2; ++n)
#pragma unroll
                    for (int j = 0; j < 4; ++j) { v0[4 * n + j] = acc[ai][0][m][n][j]; v1[4 * n + j] = acc[ai][1][m][n][j]; }
                E.elem8(cur.pm * 256 + ai * 128 + wr * 64 + m * 16 + fr, cur.pn, wc * 32 + 8 * fq, v0, v1, cur.atomic);
                asm volatile("" ::: "memory");
            }
        if (!has_next) break;
#pragma unroll
        for (int a = 0; a < 2; ++a)
#pragma unroll
            for (int b = 0; b < 2; ++b)
#pragma unroll
                for (int m = 0; m < 4; ++m)
#pragma unroll
                    for (int n = 0; n < 2; ++n) acc[a][b][m][n] = (f32x4){0.f, 0.f, 0.f, 0.f};
        cur = nxt; cA = nA; cB = nB; ++ui;
        if (wr == 1) PG8_BAR;
    }
    PG8_WAIT_V(0);
    PG8_BAR;
#undef PG8_SA
#undef PG8_SB
#undef PG8_GLDS
#undef PG8_STAGE_A
#undef PG8_STAGE_B
#undef PG8_LDA
#undef PG8_LDB
#undef PG8_MMA
#undef PG8_CAT
#undef PG8_WAIT_V
#undef PG8_WAIT_L
#undef PG8_BAR
#undef PG8_SCHED
#undef PG8_GOFFS
}
}
#ifndef NAIVE_GEMM
#define NAIVE_GEMM 0
#endif
template <bool GATHER, bool F8 = false, class Epi, class Sched>
DI void gemm_phase(const Ctx& c, const GemmP g, const Sched& S, const Epi& E) {
#if NAIVE_GEMM
    gemm_phase_naive(c, g, S, E);
#else
    pg8::gemm_phase<GATHER, F8>((LAS unsigned char*)c.lds, g, S, E);
#endif
}

template <class F>
DI void conv_matrix(const Ctx& c, F f, int K, int Ndst, bf16_t* WT) {
    float* scr = (float*)c.wscr;
    const int nblk = Ndst / 32, nitems = (K / 64) * nblk, lane = c.lane;
    for (int item = c.gw; item < nitems; item += c.ngw) {
        const int kb = item / nblk, nb = item % nblk, k0 = 64 * kb, n0 = 32 * nb;
#pragma unroll 8
        for (int i = 0; i < 32; ++i) { const int kk = 2 * i + (lane >> 5); scr[kk * 33 + (lane & 31)] = f(n0 + (lane & 31), k0 + kk); }
        asm volatile("s_waitcnt lgkmcnt(0)" ::: "memory");
        const int cc = lane & 7;
#pragma unroll
        for (int j = 0; j < 4; ++j) { const int n = (lane >> 3) + 8 * j; const float* s = scr + (8 * cc) * 33 + n;
            v4u o; o.x = pk2(s[0 * 33], s[1 * 33]); o.y = pk2(s[2 * 33], s[3 * 33]); o.z = pk2(s[4 * 33], s[5 * 33]); o.w = pk2(s[6 * 33], s[7 * 33]);
            *(v4u*)(WT + (size_t)(n0 + n) * K + k0 + 8 * cc) = o; }
        asm volatile("s_waitcnt lgkmcnt(0)" ::: "memory");
    }
}
template <class F>
DI void conv_matrix8(const Ctx& c, F f, int K, int Ndst, unsigned char* WT, float scale) {
    float* scr = (float*)c.wscr;
    const int nblk = Ndst / 32, nitems = (K / 64) * nblk, lane = c.lane;
    for (int item = c.gw; item < nitems; item += c.ngw) {
        const int kb = item / nblk, nb = item % nblk, k0 = 64 * kb, n0 = 32 * nb;
#pragma unroll 8
        for (int i = 0; i < 32; ++i) { const int kk = 2 * i + (lane >> 5); scr[kk * 33 + (lane & 31)] = f(n0 + (lane & 31), k0 + kk) * scale; }
        asm volatile("s_waitcnt lgkmcnt(0)" ::: "memory");
        const int cc = lane & 7;
#pragma unroll
        for (int j = 0; j < 4; ++j) { const int n = (lane >> 3) + 8 * j; const float* s = scr + (8 * cc) * 33 + n;
            v2u o; o.x = pk4f8(s[0 * 33], s[1 * 33], s[2 * 33], s[3 * 33]); o.y = pk4f8(s[4 * 33], s[5 * 33], s[6 * 33], s[7 * 33]);
            *(v2u*)(WT + (size_t)(n0 + n) * K + k0 + 8 * cc) = o; }
        asm volatile("s_waitcnt lgkmcnt(0)" ::: "memory");
    }
}
struct SrcPlain { const float* W; int N; DI float operator()(int n, int k) const { return W[(size_t)k * N + n]; } };
struct SrcMix {
    const float* W;
    DI float operator()(int n, int k) const {
        int col;
        if (n < 256) col = 384 + n;
        else if (n < 640) col = n - 256;
        else if (n < 672) col = 640 + (n - 640);
        else if (n < 704) col = 2464 + (n - 672);
        else if (n < 712) col = 2496 + (n - 704);
        else if (n < 768) col = -1;
        else if (n < 1792) {
            const int m = n - 768, isk = m >= 512, mm = m & 511, tq = mm >> 8, cc = mm & 255, bj = cc >> 7, wc = (cc >> 5) & 3, i = cc & 31;
            col = (isk ? 1184 : 672) + (tq * 4 + wc) * 64 + 32 * bj + i; }
        else if (n < 2304) col = 1696 + (n - 1792);
        else col = 2208 + (n - 2304);
        return col < 0 ? 0.f : W[(size_t)k * MIXIN + col];
    }
};
struct SrcPlainG { const float* W; int N; const float* g; DI float operator()(int n, int k) const { return W[(size_t)k * N + n] * g[k]; } };
struct SrcGlu { const float* W1; const float* W3; DI float operator()(int n, int k) const { const int t = n >> 8, j = n & 255;
    const uintptr_t d = (uintptr_t)W3 - (uintptr_t)W1; const float* W = (const float*)((uintptr_t)W1 + (j < 128 ? (uintptr_t)0 : d)); return W[(size_t)k * DFF + t * 128 + (j & 127)]; } };

template <bool F8>
DI void conv_tile(const Ctx& c, const float* src0, int ld, void* WT, int K, int n0, int k0, float scale) {
    constexpr int KT = F8 ? 128 : 64, NL = KT / 8;
    LAS float* scr = (LAS float*)((LAS unsigned char*)c.lds + c.wave * WSCR);
    const int lane = c.lane;
    const float* src = src0 + (size_t)(lane >> 3) * ld + (lane & 7) * 4;
    f32x4 v[NL];
#pragma unroll
    for (int i = 0; i < NL; ++i) v[i] = *(const f32x4*)(src + (size_t)(8 * i) * ld);
#pragma unroll
    for (int i = 0; i < NL; ++i) { LAS float* q = scr + (8 * i + (lane >> 3)) * 33 + (lane & 7) * 4; q[0] = v[i].x * scale; q[1] = v[i].y * scale; q[2] = v[i].z * scale; q[3] = v[i].w * scale; }
    const int n = lane & 31, kc = lane >> 5;
#pragma unroll
    for (int j = 0; j < 4; ++j) {
        if constexpr (F8) { const int k = 64 * kc + 16 * j; const LAS float* q = scr + k * 33 + n; v4u o;
            o.x = pk4f8(q[0], q[33], q[66], q[99]); o.y = pk4f8(q[4 * 33], q[5 * 33], q[6 * 33], q[7 * 33]); o.z = pk4f8(q[8 * 33], q[9 * 33], q[10 * 33], q[11 * 33]); o.w = pk4f8(q[12 * 33], q[13 * 33], q[14 * 33], q[15 * 33]);
            *(v4u*)((unsigned char*)WT + (size_t)(n0 + n) * K + k0 + k) = o; }
        else { const int k = 32 * kc + 8 * j; const LAS float* q = scr + k * 33 + n; v4u o;
            o.x = pk2(q[0], q[33]); o.y = pk2(q[2 * 33], q[3 * 33]); o.z = pk2(q[4 * 33], q[5 * 33]); o.w = pk2(q[6 * 33], q[7 * 33]);
            *(v4u*)((bf16_t*)WT + (size_t)(n0 + n) * K + k0 + k) = o; }
    }
}
template <bool F8, class P>
DI void conv_fast(const Ctx& c, P p, int K, int Ndst, void* WT, float scale, int& rot) {
    constexpr int KT = F8 ? 128 : 64;
    const int nblk = Ndst / 32, nitems = (K / KT) * nblk;
    int first = (c.gw - rot) % c.ngw; if (first < 0) first += c.ngw;
    rot = (rot + nitems) % c.ngw;
    for (int item = first; item < nitems; item += c.ngw) {
        const int kb = item / nblk, nb = item % nblk, k0 = KT * kb, n0 = 32 * nb;
        conv_tile<F8>(c, p.row(n0, k0), p.ld, WT, K, n0, k0, scale);
    }
}
struct RowPlain { const float* W; int ld; DI const float* row(int n0, int k0) const { return W + (size_t)k0 * ld + n0; } };
struct RowGlu { const float* W1; const float* W3; int ld; DI const float* row(int n0, int k0) const { const int t = n0 >> 8, j = n0 & 255;
    const uintptr_t d = (uintptr_t)W3 - (uintptr_t)W1; const float* W = (const float*)((uintptr_t)W1 + (j < 128 ? (uintptr_t)0 : d)); return W + (size_t)k0 * ld + t * 128 + (j & 127); } };

constexpr int MOE_IT13 = (D / 128) * (2 * DFF / 32), MOE_IT2 = (DFF / 128) * (D / 32);
template <int KIND>
DI void moe_conv_items(const Ctx& c, const float* const* in, unsigned char* ws, int lo, int hi, int w, int nw) {
    for (int g = lo + w; g < hi; g += nw) {
        if constexpr (KIND == 0) { const int e = g / MOE_IT13, item = g % MOE_IT13, nblk = 2 * DFF / 32, kb = item / nblk, nb = item % nblk, k0 = 128 * kb, n0 = 32 * nb;
            const RowGlu p{in[24] + (size_t)e * D * DFF, in[25] + (size_t)e * D * DFF, DFF};
            conv_tile<true>(c, p.row(n0, k0), DFF, ws + WS_MW13 + (size_t)e * 2 * DFF * D, D, n0, k0, F8_SW1); }
        else { const int e = g / MOE_IT2, item = g % MOE_IT2, nblk = D / 32, kb = item / nblk, nb = item % nblk, k0 = 128 * kb, n0 = 32 * nb;
            conv_tile<true>(c, in[26] + (size_t)e * DFF * D + (size_t)k0 * D + n0, D, ws + WS_MW2 + (size_t)e * D * DFF, DFF, n0, k0, F8_SW2); }
    }
}
DI bool idle_slot(const Ctx& c, int nwg, int& w, int& nw) { const int busy = nwg % c.G; if (busy == 0 || c.bid < busy) return false; w = (c.bid - busy) * 8 + c.wave; nw = (c.G - busy) * 8; return true; }
constexpr int IDLE_PER_WAVE = 3;
DI int idle_items(int G, int nwg, int cap) { const int busy = nwg % G; const int n = busy ? IDLE_PER_WAVE * 8 * (G - busy) : 0; return n < cap ? n : cap; }
constexpr int NWG_MIXIN = MP / 256 * (MIXN / 256), NWG_FFN1 = MP / 256 * (2 * DFF / 256), NWG_WIN = MP / 256 * 12;

DI void rms_row_to_bf16(const f32x4 (&v)[4], const float* g, bf16_t* orow, int lane) {
    float ss = 0.f;
#pragma unroll
    for (int j = 0; j < 4; ++j) ss += (v[j].x * v[j].x + v[j].y * v[j].y) + (v[j].z * v[j].z + v[j].w * v[j].w);
    const float rstd = 1.0f / sqrtf(wave_sum(ss) * (1.f / D) + EPS);
#pragma unroll
    for (int j = 0; j < 4; ++j) { const f32x4 gg = *(const f32x4*)(g + 4 * lane + 256 * j);
        v2u o; o.x = pk2(v[j].x * rstd * gg.x, v[j].y * rstd * gg.y); o.y = pk2(v[j].z * rstd * gg.z, v[j].w * rstd * gg.w);
        *(v2u*)(orow + 4 * lane + 256 * j) = o; }
}
DI void phase_prologue_rows(const Ctx& c, const float* x, const float* meta, const float* g, bf16_t* h, bf16_t* XN) {
    for (int m = c.gw; m < MP; m += c.ngw) {
        const int b = m / LP, t = m % LP;
        const float* src = t < NMETA ? meta + (size_t)t * D : (t < LTOT ? x + ((size_t)b * SEQ + (t - NMETA)) * D : nullptr);
        f32x4 v[4];
#pragma unroll
        for (int j = 0; j < 4; ++j) v[j] = src ? *(const f32x4*)(src + 4 * c.lane + 256 * j) : (f32x4){0.f, 0.f, 0.f, 0.f};
#pragma unroll
        for (int j = 0; j < 4; ++j) { v2u o; o.x = pk2(v[j].x, v[j].y); o.y = pk2(v[j].z, v[j].w); *(v2u*)(h + (size_t)m * D + 4 * c.lane + 256 * j) = o; }
        rms_row_to_bf16(v, g, XN + (size_t)m * D, c.lane);
    }
}
DI void phase_norm_rows(const Ctx& c, bf16_t* h, const float* g, bf16_t* XN, int nrows, const StaticSched& S, const float* part) {
    const int tail = S.nwg - S.full;
    for (int m = c.gw; m < nrows; m += c.ngw) {
        f32x4 v[4];
#pragma unroll
        for (int j = 0; j < 4; ++j) { const v2u w = *(const v2u*)(h + (size_t)m * D + 4 * c.lane + 256 * j); v[j] = (f32x4){lo2f(w.x), hi2f(w.x), lo2f(w.y), hi2f(w.y)}; }
        if (tail > 0) {
            bool any = false;
#pragma unroll
            for (int j = 0; j < 4; ++j) { const int L = S.index_of(m >> 8, j);
                if (L >= S.full) { any = true; const float* p = part + ((size_t)(L - S.full) * S.S * 256 + (m & 255)) * 256 + 4 * c.lane;
                    for (int kc = 0; kc < S.S; ++kc) v[j] += *(const f32x4*)(p + (size_t)kc * 65536);
                    v2u o; o.x = pk2(v[j].x, v[j].y); o.y = pk2(v[j].z, v[j].w); *(v2u*)(h + (size_t)m * D + 4 * c.lane + 256 * j) = o;
                    v[j] = (f32x4){lo2f(o.x), hi2f(o.x), lo2f(o.y), hi2f(o.y)}; } }
            (void)any;
        }
        rms_row_to_bf16(v, g, XN + (size_t)m * D, c.lane);
    }
}
template <int NN, int SLOT>
DI void phase_moe_fix(const Ctx& c, const MoeSched<NN>& S, const int* rowtok, const float* rowgate, const float* part, float* out, float sc, bf16_t* parta, const bf16_t* h3) {
    const int tail = S.nM * NN - S.full;
    int lane_ = c.lane; asm volatile("" : "+v"(lane_));
    for (int it = c.gw; it < tail * 256; it += c.ngw) {
        const int ti = it >> 8, r = it & 255, id = S.full + ti, pm = id / NN, pn = id % NN;
        const int tok = rowtok[pm * 256 + r]; if (tok < 0) continue;
        const float gt = rowgate[pm * 256 + r] * sc;
        const float* p = part + ((size_t)ti * S.S * 256 + r) * 256 + 4 * lane_;
        f32x4 a = (f32x4){0.f, 0.f, 0.f, 0.f};
        for (int kc = 0; kc < S.S; ++kc) a += *(const f32x4*)(p + (size_t)kc * 65536);
        a = a * gt;
        const size_t e = (size_t)tok * D + pn * 256 + 4 * lane_;
        if constexpr (SLOT == 0) { v2u o; o.x = pk2(a.x, a.y); o.y = pk2(a.z, a.w); *(v2u*)(parta + e) = o; }
        else { const v2u pa = *(const v2u*)(parta + e), hh = *(const v2u*)(h3 + e);
            a += (f32x4){lo2f(pa.x) + lo2f(hh.x), hi2f(pa.x) + hi2f(hh.x), lo2f(pa.y) + lo2f(hh.y), hi2f(pa.y) + hi2f(hh.y)};
            *(f32x4*)(out + e) = a; }
    }
}
DI void transpose_v(const Ctx& c, const bf16_t* src, int pitch, int col0, int hstride, bf16_t* VT) {
    bf16_t* scr = (bf16_t*)c.wscr;
    const int lane = c.lane, nitems = NB * (LP / 64) * 8;
    for (int it = c.gw; it < nitems; it += c.ngw) {
        const int h = it & 7, tt = (it >> 3) % (LP / 64), b = (it >> 3) / (LP / 64), t0 = tt * 64;
        const bf16_t* sp = src + ((size_t)b * LP + t0) * pitch + col0 + h * hstride;
#pragma unroll
        for (int i = 0; i < 8; ++i) { const int r = i * 8 + (lane >> 3), ch = lane & 7; const v4u w = *(const v4u*)(sp + (size_t)r * pitch + ch * 8);
            unsigned* d = (unsigned*)(scr + r * 66 + ch * 8); d[0] = w.x; d[1] = w.y; d[2] = w.z; d[3] = w.w; }
        asm volatile("s_waitcnt lgkmcnt(0)" ::: "memory");
        bf16_t* dp = VT + ((size_t)(b * 8 + h) * 64) * LP + t0;
#pragma unroll
        for (int i = 0; i < 8; ++i) { const int d = i * 8 + (lane >> 3), ch = lane & 7;
            const bf16_t* s = scr + ((ch >> 1) * 16 + (ch & 1) * 4) * 66 + d;
            v4u o; o.x = (unsigned)s[0] | ((unsigned)s[66] << 16); o.y = (unsigned)s[2 * 66] | ((unsigned)s[3 * 66] << 16);
            o.z = (unsigned)s[8 * 66] | ((unsigned)s[9 * 66] << 16); o.w = (unsigned)s[10 * 66] | ((unsigned)s[11 * 66] << 16);
            *(v4u*)(dp + (size_t)d * LP + ch * 8) = o; }
        asm volatile("s_waitcnt lgkmcnt(0)" ::: "memory");
    }
}
DI void phase_ew2(const Ctx& c, bf16_t* LAT, bf16_t* DQ, bf16_t* DK, bf16_t* KR, bf16_t* IK, float* IW,
                  const float* g_q_lat, const float* g_kv_lat, const float* g_dq, const float* g_dk) {
    const int lane = c.lane;
    for (int m = c.gw; m < MP; m += c.ngw) {
        bf16_t* L = LAT + (size_t)m * 768;
        {
            const v2u w = *(const v2u*)(L + 4 * lane);
            const float a = lo2f(w.x), b = hi2f(w.x), cc = lo2f(w.y), d = hi2f(w.y);
            const float rstd = 1.0f / sqrtf(wave_sum(a * a + b * b + cc * cc + d * d) * (1.f / KVR) + EPS);
            const f32x4 g = *(const f32x4*)(g_kv_lat + 4 * lane);
            v2u o; o.x = pk2(a * rstd * g.x, b * rstd * g.y); o.y = pk2(cc * rstd * g.z, d * rstd * g.w);
            *(v2u*)(L + 4 * lane) = o;
        }
        {
            unsigned* p = (unsigned*)(L + 256 + 6 * lane);
            const unsigned w0 = p[0], w1 = p[1], w2 = p[2];
            float v[6] = {lo2f(w0), hi2f(w0), lo2f(w1), hi2f(w1), lo2f(w2), hi2f(w2)};
            float ss = 0.f;
#pragma unroll
            for (int i = 0; i < 6; ++i) ss += v[i] * v[i];
            const float rstd = 1.0f / sqrtf(wave_sum(ss) * (1.f / QR) + EPS);
#pragma unroll
            for (int i = 0; i < 6; ++i) v[i] = v[i] * rstd * g_q_lat[6 * lane + i];
            p[0] = pk2(v[0], v[1]); p[1] = pk2(v[2], v[3]); p[2] = pk2(v[4], v[5]);
        }
        {
            const unsigned* L32 = (const unsigned*)L;
            if (lane < 16) ((unsigned*)KR)[(size_t)m * 16 + lane] = L32[320 + lane];
            else if (lane < 32) ((unsigned*)IK)[(size_t)m * 16 + (lane - 16)] = L32[336 + (lane - 16)];
            else if (lane < 40) IW[(size_t)m * 8 + (lane - 32)] = bf2f(L[704 + (lane - 32)]);
        }
#pragma unroll
        for (int which = 0; which < 2; ++which) {
            bf16_t* p = (which == 0 ? DQ : DK) + (size_t)m * 512 + 8 * lane;
            const float* g = (which == 0 ? g_dq : g_dk) + 8 * (lane & 7);
            float v[8]; unpack8(*(const v4u*)p, v);
            float ss = 0.f;
#pragma unroll
            for (int i = 0; i < 8; ++i) ss += v[i] * v[i];
            ss += __shfl_xor(ss, 1); ss += __shfl_xor(ss, 2); ss += __shfl_xor(ss, 4);
            const float rstd = 1.0f / sqrtf(ss * (1.f / 64.f) + EPS) * (which == 0 ? DSA_QS : 1.f);
#pragma unroll
            for (int i = 0; i < 8; ++i) v[i] = v[i] * rstd * g[i];
            *(v4u*)p = pack8(v);
        }
    }
}
__device__ const double ROPE_INV[16] = {1.0, 0.5623413251903491, 0.31622776601683794, 0.1778279410038923, 0.1, 0.05623413251903491, 0.03162277660168379, 0.01778279410038923,
    0.01, 0.005623413251903491, 0.0031622776601683794, 0.0017782794100389228, 0.001, 0.0005623413251903491, 0.00031622776601683794, 0.00017782794100389227};
DI void rope_cs(int t, int i, float& cs, float& sn) {
    const float inv = (float)ROPE_INV[i]; const float ang = (float)t * inv;
    double rev = (double)ang * 0.15915494309189535; rev -= __builtin_rint(rev);
    const float fr = (float)rev; cs = __builtin_amdgcn_cosf(fr); sn = __builtin_amdgcn_sinf(fr);
}
DI void phase_ew4(const Ctx& c, bf16_t* Qm, const bf16_t* KV, const bf16_t* KR, bf16_t* Km, const float* g_qn, const float* g_kn) {
    float* scr = (float*)c.wscr; const int lane = c.lane;
    for (int m = c.gw; m < MP; m += c.ngw) {
        const int t = m % LP;
        float cs[2], sn[2];
#pragma unroll
        for (int e = 0; e < 2; ++e) rope_cs(t, (lane * 2 + e) & 15, cs[e], sn[e]);
        {
            unsigned* p = (unsigned*)(Qm + (size_t)m * MLAW + 12 * lane);
            float v[12];
#pragma unroll
            for (int i = 0; i < 6; ++i) { const unsigned w = p[i]; v[2 * i] = lo2f(w); v[2 * i + 1] = hi2f(w); }
            float ss = 0.f;
#pragma unroll
            for (int i = 0; i < 12; ++i) ss += v[i] * v[i];
            ss += __shfl_xor(ss, 1); ss += __shfl_xor(ss, 2); ss += __shfl_xor(ss, 4);
            const float rstd = 1.0f / sqrtf(ss * (1.f / MQK) + EPS);
#pragma unroll
            for (int i = 0; i < 12; ++i) scr[12 * lane + i] = v[i] * rstd * g_qn[12 * (lane & 7) + i];
            asm volatile("s_waitcnt lgkmcnt(0)" ::: "memory");
#pragma unroll
            for (int e = 0; e < 2; ++e) { const int pr = lane * 2 + e, hh = pr >> 4, i = pr & 15; float* q = scr + hh * 96 + 64;
                const float x1 = q[i], x2 = q[16 + i]; q[i] = x1 * cs[e] - x2 * sn[e]; q[16 + i] = x1 * sn[e] + x2 * cs[e]; }
            asm volatile("s_waitcnt lgkmcnt(0)" ::: "memory");
#pragma unroll
            for (int i = 0; i < 6; ++i) p[i] = pk2(scr[12 * lane + 2 * i] * MLA_QS, scr[12 * lane + 2 * i + 1] * MLA_QS);
            asm volatile("s_waitcnt lgkmcnt(0)" ::: "memory");
        }
        {
            const int hh = lane >> 3, sub = lane & 7;
            float kn[8]; unpack8(*(const v4u*)(KV + (size_t)m * 1024 + hh * 128 + 8 * sub), kn);
            const v2u rw = *(const v2u*)(KR + (size_t)m * 768 + 640 + 4 * sub);
            float kr[4] = {lo2f(rw.x), hi2f(rw.x), lo2f(rw.y), hi2f(rw.y)};
            float ss = 0.f;
#pragma unroll
            for (int i = 0; i < 8; ++i) ss += kn[i] * kn[i];
#pragma unroll
            for (int i = 0; i < 4; ++i) ss += kr[i] * kr[i];
            ss += __shfl_xor(ss, 1); ss += __shfl_xor(ss, 2); ss += __shfl_xor(ss, 4);
            const float rstd = 1.0f / sqrtf(ss * (1.f / MQK) + EPS);
#pragma unroll
            for (int i = 0; i < 8; ++i) scr[hh * 96 + 8 * sub + i] = kn[i] * rstd * g_kn[8 * sub + i];
#pragma unroll
            for (int i = 0; i < 4; ++i) scr[hh * 96 + 64 + 4 * sub + i] = kr[i] * rstd * g_kn[64 + 4 * sub + i];
            asm volatile("s_waitcnt lgkmcnt(0)" ::: "memory");
#pragma unroll
            for (int e = 0; e < 2; ++e) { const int pr = lane * 2 + e, h2 = pr >> 4, i = pr & 15; float* q = scr + h2 * 96 + 64;
                const float x1 = q[i], x2 = q[16 + i]; q[i] = x1 * cs[e] - x2 * sn[e]; q[16 + i] = x1 * sn[e] + x2 * cs[e]; }
            asm volatile("s_waitcnt lgkmcnt(0)" ::: "memory");
            unsigned* p = (unsigned*)(Km + (size_t)m * MLAW + 12 * lane);
#pragma unroll
            for (int i = 0; i < 6; ++i) p[i] = pk2(scr[12 * lane + 2 * i], scr[12 * lane + 2 * i + 1]);
            asm volatile("s_waitcnt lgkmcnt(0)" ::: "memory");
        }
    }
}
DI void phase_conv(const Ctx& c, const bf16_t* Z2, const float* cw, bf16_t* YC) {
    const int lane = c.lane;
    for (int r = c.gw; r < MR; r += c.ngw) {
        const int b = r >> 12, tt = r & 4095; const size_t m = (size_t)b * LP + NMETA + tt;
#pragma unroll
        for (int j = 0; j < 4; ++j) { const int col = 4 * lane + 256 * j;
            f32x4 y = (f32x4){0.f, 0.f, 0.f, 0.f};
#pragma unroll
            for (int k = 0; k < 3; ++k) { const v2u zz = *(const v2u*)(Z2 + (m - 2 + k) * 2048 + col); const f32x4 w = *(const f32x4*)(cw + k * 1024 + col);
                y.x += w.x * lo2f(zz.x); y.y += w.y * hi2f(zz.x); y.z += w.z * lo2f(zz.y); y.w += w.w * hi2f(zz.y); }
            const v2u bg = *(const v2u*)(Z2 + m * 2048 + 1024 + col);
            v2u o; o.x = pk2(lo2f(bg.x) * y.x, hi2f(bg.x) * y.y); o.y = pk2(lo2f(bg.y) * y.z, hi2f(bg.y) * y.w);
            *(v2u*)(YC + (size_t)r * D + col) = o; }
    }
}
DI void phase_route(const Ctx& c, const bf16_t* h, const float* g, const float* wr, unsigned char* XN2, unsigned* cnt, int* asg, float* gate) {
    float* wt = (float*)c.lds;
    LAS unsigned* lcnt = (LAS unsigned*)((LAS unsigned char*)c.lds + 32768);
    LAS unsigned* lrec = lcnt + 32;
    __syncthreads();
    for (int i = c.tid; i < D * NE; i += 512) { const int k = i >> 3, e = i & 7; wt[e * D + k] = wr[i]; }
    if (c.tid < 32) lcnt[c.tid] = 0u;
    __syncthreads();
    const int lane = c.lane; int kk = 0;
    for (int r = c.gw; r < MR; r += c.ngw) {
        f32x4 v[4]; float ss = 0.f;
#pragma unroll
        for (int j = 0; j < 4; ++j) { const v2u w = *(const v2u*)(h + (size_t)r * D + 4 * lane + 256 * j); v[j] = (f32x4){lo2f(w.x), hi2f(w.x), lo2f(w.y), hi2f(w.y)}; ss += (v[j].x * v[j].x + v[j].y * v[j].y) + (v[j].z * v[j].z + v[j].w * v[j].w); }
        const float rstd = 1.0f / sqrtf(wave_sum(ss) * (1.f / D) + EPS);
        float lg[NE];
#pragma unroll
        for (int e = 0; e < NE; ++e) lg[e] = 0.f;
#pragma unroll
        for (int j = 0; j < 4; ++j) { const f32x4 gg = *(const f32x4*)(g + 4 * lane + 256 * j);
            const f32x4 xn = (f32x4){v[j].x * rstd * gg.x, v[j].y * rstd * gg.y, v[j].z * rstd * gg.z, v[j].w * rstd * gg.w};
            *(unsigned*)(XN2 + (size_t)r * D + 4 * lane + 256 * j) = pk4f8(xn.x * F8_SX, xn.y * F8_SX, xn.z * F8_SX, xn.w * F8_SX);
#pragma unroll
            for (int e = 0; e < NE; ++e) { const f32x4 w = *(const f32x4*)(wt + e * D + 4 * lane + 256 * j); lg[e] += (xn.x * w.x + xn.y * w.y) + (xn.z * w.z + xn.w * w.w); } }
#pragma unroll
        for (int e = 0; e < NE; ++e) lg[e] = wave_sum(lg[e]);
        int e0 = 0; float v0 = lg[0];
#pragma unroll
        for (int e = 1; e < NE; ++e) if (lg[e] > v0) { v0 = lg[e]; e0 = e; }
        int e1 = -1; float v1 = -INFINITY;
#pragma unroll
        for (int e = 0; e < NE; ++e) if (e != e0 && lg[e] > v1) { v1 = lg[e]; e1 = e; }
        const float ex = __expf(v1 - v0); const float g0 = 1.f / (1.f + ex), g1 = ex / (1.f + ex);
        if (lane == 0) {
            const unsigned p0 = __hip_atomic_fetch_add(lcnt + e0, 1u, __ATOMIC_RELAXED, __HIP_MEMORY_SCOPE_WORKGROUP), p1 = __hip_atomic_fetch_add(lcnt + 8 + e1, 1u, __ATOMIC_RELAXED, __HIP_MEMORY_SCOPE_WORKGROUP);
            lrec[(c.wave * 32 + kk) * 2] = (unsigned)e0 | (p0 << 4); lrec[(c.wave * 32 + kk) * 2 + 1] = (unsigned)e1 | (p1 << 4); gate[r] = g0; gate[MR + r] = g1;
        }
        ++kk;
    }
    __syncthreads();
    if (c.tid < 16) lcnt[16 + c.tid] = __hip_atomic_fetch_add(cnt + c.tid, lcnt[c.tid], RLX_AGENT);
    __syncthreads();
    if (lane == 0) { kk = 0;
        for (int r = c.gw; r < MR; r += c.ngw, ++kk) { const unsigned a0 = lrec[(c.wave * 32 + kk) * 2], a1 = lrec[(c.wave * 32 + kk) * 2 + 1];
            asg[r] = (int)((a0 & 15u) | (((a0 >> 4) + lcnt[16 + (a0 & 15u)]) << 4)); asg[MR + r] = (int)((a1 & 15u) | (((a1 >> 4) + lcnt[16 + 8 + (a1 & 15u)]) << 4)); } }
}
DI void phase_scatter(const Ctx& c, const unsigned* cnt, const int* asg, const float* gate, int* rowtok, float* rowgate) {
    int base[2][NE];
#pragma unroll
    for (int s = 0; s < 2; ++s) { int acc = 0;
#pragma unroll
        for (int e = 0; e < NE; ++e) { base[s][e] = acc; acc += (int)((cnt[s * 8 + e] + 255u) & ~255u); } }
    const int gt = c.bid * 512 + c.tid, ngt = c.G * 512;
    for (int i = gt; i < 2 * MR; i += ngt) {
        const int s = i >= MR ? 1 : 0, r = i - s * MR; const int a = asg[i], e = a & 15, pos = a >> 4;
        int bs = 0;
#pragma unroll
        for (int k = 0; k < NE; ++k) if (k == e) bs = base[s][k];
        rowtok[s * MOE_ROWS + bs + pos] = r; rowgate[s * MOE_ROWS + bs + pos] = gate[i];
    }
}

DI void phase_mla_naive(const Ctx& c, const bf16_t* Qm, const bf16_t* Km, const bf16_t* VmT, bf16_t* O) {
    float* sc = (float*)c.wscr; const int lane = c.lane;
    for (int it = c.gw; it < MP * 8; it += c.ngw) {
        const int m = it >> 3, h = it & 7, b = m / LP, t = m % LP;
        bf16_t* op = O + (size_t)m * D + h * 64 + lane;
        if (t >= LTOT) { *op = 0; continue; }
        float q[96];
        { const bf16_t* qp = Qm + (size_t)m * MLAW + h * 96;
#pragma unroll
          for (int i = 0; i < 12; ++i) { float f[8]; unpack8(*(const v4u*)(qp + 8 * i), f);
#pragma unroll
              for (int j = 0; j < 8; ++j) q[8 * i + j] = f[j]; } }
        const int n = t + 1; float mx = -INFINITY;
        for (int s0 = 0; s0 < n; s0 += 64) { const int s = s0 + lane; float v = -INFINITY;
            if (s < n) { const bf16_t* kp = Km + ((size_t)b * LP + s) * MLAW + h * 96; float d = 0.f;
#pragma unroll
                for (int i = 0; i < 12; ++i) { float f[8]; unpack8(*(const v4u*)(kp + 8 * i), f);
#pragma unroll
                    for (int j = 0; j < 8; ++j) d += q[8 * i + j] * f[j]; }
                v = d; }
            sc[s0 + lane] = v; mx = fmaxf(mx, v); }
        mx = wave_max(mx);
        asm volatile("s_waitcnt lgkmcnt(0)" ::: "memory");
        float l = 0.f, acc = 0.f; const bf16_t* vp = VmT + ((size_t)(b * 8 + h) * 64 + lane) * LP;
        for (int s0 = 0; s0 < ((n + 15) & ~15); s0 += 8) {
            v4u w = *(const v4u*)(vp + s0); float f[8]; unpack8(w, f);
#pragma unroll
            for (int j = 0; j < 8; ++j) { const int pp = (s0 + j) & 15; const int s = ((s0 + j) & ~15) + (pp < 4 ? pp : pp < 8 ? pp + 4 : pp < 12 ? pp - 4 : pp);
                if (s < n) { const float p = exp2f(sc[s] - mx); l += p; acc += p * f[j]; } }
        }
        *op = (bf16_t)f2bf(acc / l);
        asm volatile("s_waitcnt lgkmcnt(0)" ::: "memory");
    }
}
DI unsigned fkey(float f) { return (unsigned)(int)__builtin_amdgcn_fmed3f(f * 33554432.f, -2147483520.f, 2147483520.f) ^ 0x80000000u; }
DI void phase_dsa_naive(const Ctx& c, const bf16_t* DQ, const bf16_t* DK, const bf16_t* DV, const bf16_t* IQ, const bf16_t* IK, const float* IW, const float* lut, bf16_t* O) {
    unsigned* key = (unsigned*)c.wscr;
    float* qf = (float*)(c.wscr + 16448);
    unsigned short* sel = (unsigned short*)(c.wscr + 17472);
    const int lane = c.lane;
    for (int m = c.gw; m < MP; m += c.ngw) {
        const int b = m / LP, t = m % LP;
        bf16_t* op = O + (size_t)m * D + 512;
        if (t >= LTOT) { for (int i = lane; i < 512; i += 64) op[i] = 0; continue; }
        const int n = t + 1;
        {
            float f[4]; const v2u w = *(const v2u*)(IQ + (size_t)m * 256 + 4 * lane); f[0] = lo2f(w.x); f[1] = hi2f(w.x); f[2] = lo2f(w.y); f[3] = hi2f(w.y);
            *(f32x4*)(qf + 4 * lane) = (f32x4){f[0], f[1], f[2], f[3]};
        }
        float wv[8];
#pragma unroll
        for (int hh = 0; hh < 8; ++hh) wv[hh] = IW[(size_t)m * 8 + hh];
        asm volatile("s_waitcnt lgkmcnt(0)" ::: "memory");
        for (int s0 = 0; s0 < n; s0 += 64) { const int s = s0 + lane;
            if (s < n) { const bf16_t* kp = IK + ((size_t)b * LP + s) * 32; float kk[32];
#pragma unroll
                for (int i = 0; i < 4; ++i) { float f[8]; unpack8(*(const v4u*)(kp + 8 * i), f);
#pragma unroll
                    for (int j = 0; j < 8; ++j) kk[8 * i + j] = f[j]; }
                float score = 0.f;
#pragma unroll
                for (int hh = 0; hh < 8; ++hh) { float d = 0.f;
#pragma unroll
                    for (int i = 0; i < 8; ++i) { const f32x4 qq = *(const f32x4*)(qf + hh * 32 + 4 * i); d += (qq.x * kk[4 * i] + qq.y * kk[4 * i + 1]) + (qq.z * kk[4 * i + 2] + qq.w * kk[4 * i + 3]); }
                    score += wv[hh] * fmaxf(d, 0.f); }
                key[s] = fkey(score); } }
        asm volatile("s_waitcnt lgkmcnt(0)" ::: "memory");
        unsigned T = 0u; int tie = LP;
        if (n > TOPK) {
            for (int bit = 31; bit >= 0; --bit) { const unsigned cand = T | (1u << bit); int cn = 0;
                for (int s0 = 0; s0 < n; s0 += 64) { const int s = s0 + lane; const bool ge = (s < n) && key[s] >= cand; cn += __popcll(__ballot(ge)); }
                if (cn >= TOPK) T = cand; }
            int cg = 0;
            for (int s0 = 0; s0 < n; s0 += 64) { const int s = s0 + lane; cg += __popcll(__ballot((s < n) && key[s] > T)); }
            const int need = TOPK - cg; int run = 0; tie = -1;
            for (int s0 = 0; s0 < n && tie < 0; s0 += 64) { const int s = s0 + lane; unsigned long long mk = __ballot((s < n) && key[s] == T); const int pc = __popcll(mk);
                if (run + pc >= need) { int kth = need - run; while (kth > 1) { mk &= mk - 1; --kth; } tie = s0 + (int)__builtin_ctzll(mk); }
                run += pc; }
        }
        int nsel = 0;
        for (int s0 = 0; s0 < n; s0 += 64) { const int s = s0 + lane; const unsigned k = (s < n) ? key[s] : 0u;
            const bool sl = (s < n) && (k > T || (k == T && s <= tie) || n <= TOPK);
            const unsigned long long mk = __ballot(sl); const int pos = nsel + (int)__popcll(mk & ((1ull << lane) - 1ull));
            if (sl && pos < TOPK) sel[pos] = (unsigned short)s; nsel += __popcll(mk); }
        if (nsel > TOPK) nsel = TOPK;
        asm volatile("s_waitcnt lgkmcnt(0)" ::: "memory");
        float* pl = qf;
        for (int hh = 0; hh < 8; ++hh) {
            float q[64];
            { const bf16_t* qp = DQ + (size_t)m * 512 + hh * 64;
#pragma unroll
              for (int i = 0; i < 8; ++i) { float f[8]; unpack8(*(const v4u*)(qp + 8 * i), f);
#pragma unroll
                  for (int j = 0; j < 8; ++j) q[8 * i + j] = f[j]; } }
            float sv[4]; float mx = -INFINITY;
#pragma unroll
            for (int cc = 0; cc < 4; ++cc) { const int j = cc * 64 + lane; sv[cc] = -INFINITY;
                if (j < nsel) { const int s = sel[j]; const bf16_t* kp = DK + ((size_t)b * LP + s) * 512 + hh * 64; float d = 0.f;
#pragma unroll
                    for (int i = 0; i < 8; ++i) { float f[8]; unpack8(*(const v4u*)(kp + 8 * i), f);
#pragma unroll
                        for (int jj = 0; jj < 8; ++jj) d += q[8 * i + jj] * f[jj]; }
                    int dist = t - s; if (dist > 127) dist = 127;
                    sv[cc] = d + lut[dist * 8 + hh]; }
                mx = fmaxf(mx, sv[cc]); }
            mx = wave_max(mx); float l = 0.f;
#pragma unroll
            for (int cc = 0; cc < 4; ++cc) { const int j = cc * 64 + lane; const float p = (j < nsel) ? exp2f(sv[cc] - mx) : 0.f; pl[j] = p; l += p; }
            l = wave_sum(l);
            asm volatile("s_waitcnt lgkmcnt(0)" ::: "memory");
            float acc = 0.f;
            for (int j = 0; j < nsel; ++j) acc += pl[j] * bf2f(DV[((size_t)b * LP + sel[j]) * 512 + hh * 64 + lane]);
            op[hh * 64 + lane] = (bf16_t)f2bf(acc / l);
            asm volatile("s_waitcnt lgkmcnt(0)" ::: "memory");
        }
    }
}


typedef short bf16x8_t __attribute__((ext_vector_type(8)));
typedef float f32x16 __attribute__((ext_vector_type(16)));
template <int NREG>
DI void select_row(const LAS unsigned* kb, LAS unsigned* hist, int n, int lane, unsigned long long* mrow) {
    unsigned k[NREG];
#pragma unroll
    for (int r = 0; r < NREG; ++r) { const int s = r * 64 + lane; k[r] = (s < n) ? kb[s] : 0u; }
    unsigned P = 0u; int need = TOPK; bool exact = false; unsigned T = 0u; int neq = 0;
#pragma unroll 1
    for (int level = 0; level < 4; ++level) {
        const int shift = 24 - 8 * level;
        if (level > 0) {
            *(LAS v4u*)(hist + 4 * lane) = (v4u){0u, 0u, 0u, 0u};
            asm volatile("s_waitcnt lgkmcnt(0)" ::: "memory");
#pragma unroll
            for (int r = 0; r < NREG; ++r) { const unsigned bin = ((k[r] >> (shift + 8)) == P) ? ((k[r] >> shift) & 255u) : (256u + (unsigned)lane);
                __hip_atomic_fetch_add(hist + bin, 1u, __ATOMIC_RELAXED, __HIP_MEMORY_SCOPE_WORKGROUP); }
            asm volatile("s_waitcnt lgkmcnt(0)" ::: "memory");
        }
        const v4u h = *(const LAS v4u*)(hist + 4 * lane);
        const int h0 = (int)h.x, h1 = (int)h.y, h2 = (int)h.z, h3 = (int)h.w, sl = h0 + h1 + h2 + h3;
        int incl = sl;
        incl += __builtin_amdgcn_update_dpp(0, incl, 0x101, 0xf, 0xf, true);
        incl += __builtin_amdgcn_update_dpp(0, incl, 0x102, 0xf, 0xf, true);
        incl += __builtin_amdgcn_update_dpp(0, incl, 0x104, 0xf, 0xf, true);
        incl += __builtin_amdgcn_update_dpp(0, incl, 0x108, 0xf, 0xf, true);
        { const int t1 = __builtin_amdgcn_readlane(incl, 16), t2 = __builtin_amdgcn_readlane(incl, 32), t3 = __builtin_amdgcn_readlane(incl, 48);
          incl += lane < 16 ? t1 + t2 + t3 : (lane < 32 ? t2 + t3 : (lane < 48 ? t3 : 0)); }
        const int a3 = incl - sl, a2 = a3 + h3, a1 = a2 + h2, a0 = a1 + h1;
        int bsel = -1, asel = 0, hsel = 0;
        if (a3 < need && need <= a3 + h3) { bsel = 3; asel = a3; hsel = h3; }
        if (a2 < need && need <= a2 + h2) { bsel = 2; asel = a2; hsel = h2; }
        if (a1 < need && need <= a1 + h1) { bsel = 1; asel = a1; hsel = h1; }
        if (a0 < need && need <= a0 + h0) { bsel = 0; asel = a0; hsel = h0; }
        const unsigned long long mk = __ballot(bsel >= 0);
        const int src = (int)__builtin_ctzll(mk);
        const int bb = __builtin_amdgcn_readlane(bsel, src), aa = __builtin_amdgcn_readlane(asel, src), hh = __builtin_amdgcn_readlane(hsel, src);
        P = (P << 8) | (unsigned)(4 * src + bb); need -= aa; neq = hh;
        if (hh == need) { exact = true; T = P << shift; break; }
        T = P;
    }
    int tie = LP;
    if (!exact) {
        int run = 0; tie = -1;
#pragma unroll
        for (int r = 0; r < NREG; ++r) { unsigned long long mk = __ballot(k[r] == T); const int pc = (int)__popcll(mk);
            if (tie < 0 && pc > 0 && run + pc >= need) { int kth = need - run; while (kth > 1) { mk &= mk - 1; --kth; } tie = r * 64 + (int)__builtin_ctzll(mk); }
            run += pc; }
    }
    unsigned long long* mp = mrow;
    if (exact) {
#pragma unroll
        for (int r = 0; r < NREG; ++r) { const unsigned long long mk = __ballot(k[r] >= T); if (lane == 0) *mp = mk; mp += LP; asm volatile("" : "+v"(mp)); }
    } else {
#pragma unroll
        for (int r = 0; r < NREG; ++r) { const int s = r * 64 + lane;
            const bool sl = (k[r] > T || (k[r] == T && s <= tie));
            const unsigned long long mk = __ballot(sl && s < n);
            if (lane == 0) *mp = mk; mp += LP; asm volatile("" : "+v"(mp)); }
    }
    *(LAS v4u*)(hist + 4 * lane) = (v4u){0u, 0u, 0u, 0u};
}
DI void phase_select(const Ctx& c, const bf16_t* IQ, const bf16_t* IWC, const bf16_t* IKC, unsigned long long* maskw, unsigned* ticket, volatile LAS unsigned* misc) {
    LAS unsigned char* lds = (LAS unsigned char*)c.lds;
    const int lane = c.lane, w = c.wave, r32 = lane & 31, hi = lane >> 5;
    LAS unsigned* hist = (LAS unsigned*)(lds + 8 * LP * 4) + w * 320;
    *(LAS v4u*)(hist + 4 * lane) = (v4u){0u, 0u, 0u, 0u};
    int par = 0;
    asm volatile("s_waitcnt lgkmcnt(0)" ::: "memory"); __builtin_amdgcn_s_barrier(); asm volatile("" ::: "memory");
    for (unsigned k = (unsigned)c.bid; k < (unsigned)(MP / 8); ) {
        unsigned nk = 0u; if (c.tid == 0) nk = (unsigned)c.G + __hip_atomic_fetch_add(ticket, 1u, RLX_AGENT);
        const int b = (int)(k & 7u), t0 = (LP / 8 - 1 - (int)(k >> 3)) * 8, t = t0 + w;
        unsigned long long* mrow = maskw + (size_t)b * 66 * LP + t;
        if (t0 + 8 <= TOPK || t0 >= LTOT) {
            for (int j = lane; j < 66; j += 64) { const int rem = t + 1 - 64 * j; mrow[(size_t)j * LP] = rem >= 64 ? ~0ull : (rem <= 0 ? 0ull : ((1ull << rem) - 1ull)); }
            par ^= 1; if (c.tid == 0) misc[24 + par] = nk;
            asm volatile("s_waitcnt vmcnt(0) lgkmcnt(0)" ::: "memory"); __builtin_amdgcn_s_barrier(); asm volatile("" ::: "memory");
            k = misc[24 + par];
            continue;
        }
        const int nmax = t0 + 8;
        bf16x8_t afr[2][2]; v4u wq[2][2];
        { const int qq = 2 * ((r32 >> 2) & 1) + (r32 >> 4), hh = (r32 & 3) + 4 * ((r32 >> 3) & 1);
#pragma unroll
          for (int rb = 0; rb < 2; ++rb)
#pragma unroll
              for (int kk = 0; kk < 2; ++kk) afr[rb][kk] = *(const bf16x8_t*)(IQ + ((size_t)b * LP + t0 + 4 * rb + qq) * 256 + hh * 32 + 16 * kk + 8 * hi);
#pragma unroll
          for (int rb = 0; rb < 2; ++rb)
#pragma unroll
              for (int e = 0; e < 2; ++e) wq[rb][e] = *(const v4u*)(IWC + ((size_t)b * LP + t0 + 4 * rb + 2 * hi + e) * 8); }
        const int nkb = (nmax + 31) >> 5;
        for (int kb0 = w; kb0 < nkb; kb0 += 32) {
            bf16x8_t bfr[4][2];
#pragma unroll
            for (int q = 0; q < 4; ++q) { int kbq = kb0 + 8 * q; if (kbq >= nkb) kbq = kb0;
                const bf16_t* kp = IKC + ((size_t)(b * 4 + hi) * LP + kbq * 32 + r32) * 8; bfr[q][0] = *(const bf16x8_t*)kp; bfr[q][1] = *(const bf16x8_t*)(kp + (size_t)2 * LP * 8); }
#pragma unroll
            for (int q = 0; q < 4; ++q) { const int kb = kb0 + 8 * q;
                if (kb < nkb) {
#pragma unroll
                    for (int rb = 0; rb < 2; ++rb) {
                        f32x16 acc = {0.f, 0.f, 0.f, 0.f, 0.f, 0.f, 0.f, 0.f, 0.f, 0.f, 0.f, 0.f, 0.f, 0.f, 0.f, 0.f};
                        acc = __builtin_amdgcn_mfma_f32_32x32x16_bf16(afr[rb][0], bfr[q][0], acc, 0, 0, 0);
                        acc = __builtin_amdgcn_mfma_f32_32x32x16_bf16(afr[rb][1], bfr[q][1], acc, 0, 0, 0);
#pragma unroll
                        for (int e = 0; e < 2; ++e) { float sc = 0.f;
#pragma unroll
                            for (int h = 0; h < 8; ++h) { const unsigned ww = h < 2 ? wq[rb][e].x : h < 4 ? wq[rb][e].y : h < 6 ? wq[rb][e].z : wq[rb][e].w; sc += ((h & 1) ? hi2f(ww) : lo2f(ww)) * fmaxf(acc[8 * e + h], 0.f); }
                            const unsigned key = fkey(sc); const int qrow_ = 4 * rb + 2 * hi + e;
                            ((LAS unsigned*)lds)[qrow_ * LP + kb * 32 + r32] = key;
                            if (kb * 32 + r32 <= t0 + qrow_) __hip_atomic_fetch_add((LAS unsigned*)(lds + 8 * LP * 4) + qrow_ * 320 + (key >> 24), 1u, __ATOMIC_RELAXED, __HIP_MEMORY_SCOPE_WORKGROUP); }
                    }
                }
            }
        }
        asm volatile("s_waitcnt lgkmcnt(0)" ::: "memory"); __builtin_amdgcn_s_barrier(); asm volatile("" ::: "memory");
        { const LAS unsigned* kbuf = (const LAS unsigned*)lds + w * LP; const int n = t + 1;
          if (n <= 33 * 64) { if (n <= 17 * 64) { if (n <= 9 * 64) select_row<9>(kbuf, hist, n, lane, mrow); else select_row<17>(kbuf, hist, n, lane, mrow); }
                              else { if (n <= 25 * 64) select_row<25>(kbuf, hist, n, lane, mrow); else select_row<33>(kbuf, hist, n, lane, mrow); } }
          else { if (n <= 50 * 64) { if (n <= 42 * 64) select_row<42>(kbuf, hist, n, lane, mrow); else select_row<50>(kbuf, hist, n, lane, mrow); }
                 else { if (n <= 58 * 64) { if (n <= 54 * 64) select_row<54>(kbuf, hist, n, lane, mrow); else select_row<58>(kbuf, hist, n, lane, mrow); }
                        else { if (n <= 62 * 64) select_row<62>(kbuf, hist, n, lane, mrow); else select_row<66>(kbuf, hist, n, lane, mrow); } } } }
        par ^= 1; if (c.tid == 0) misc[24 + par] = nk;
        asm volatile("s_waitcnt lgkmcnt(0)" ::: "memory"); __builtin_amdgcn_s_barrier(); asm volatile("" ::: "memory");
        k = misc[24 + par];
    }
}

constexpr float NEG_BIG = -1.0e30f;
constexpr int ATT_LUT_OFF = 122880;
#define SGB(mask, n) __builtin_amdgcn_sched_group_barrier((mask), (n), 0)
template <int DQK, bool DSA>
DI void attn_unit(LAS unsigned char* lds, int b, int qt, int hp, const bf16_t* Q, int qpitch, const bf16_t* K, int kpitch, const bf16_t* VT, bf16_t* O,
                  const unsigned long long* maskw, const float* lut) {
    constexpr int NPK = DQK / 8, KB = 2 * NPK * 1024, BUF = KB + 16 * 1024;
    int tid_ = threadIdx.x; asm volatile("" : "+v"(tid_));
    const int tid = tid_, lane = tid & 63, w = __builtin_amdgcn_readfirstlane(tid >> 6), r32 = lane & 31, hi = lane >> 5;
    const int hh = w >> 2, head = 2 * hp + hh, q0 = qt * 128 + (w & 3) * 32, qrow = q0 + r32;
    const size_t rowb = (size_t)b * LP;
    const int NT = 2 * qt + 2;
    if (DSA) { if (tid < 256) ((LAS float*)(lds + ATT_LUT_OFF))[tid] = lut[(tid & 127) * 8 + 2 * hp + (tid >> 7)] - lut[127 * 8 + 2 * hp + (tid >> 7)]; }
    const LAS float* lutw = (const LAS float*)(lds + ATT_LUT_OFF) + hh * 128;
    constexpr int NG = NPK / 4;
    auto issue = [&](int j, int buf) {
        const int key0 = j * 64; LAS unsigned char* base = lds + buf * BUF;
        const int kk = lane >> 2, c4 = (lane & 3) ^ ((kk >> 2) & 3);
#pragma unroll
        for (int i = 0; i < 2 * NPK / 8; ++i) { const int pi = w + 8 * i, ph = pi / NPK, rem = pi % NPK, kg = rem / NG, g = rem % NG;
            __builtin_amdgcn_global_load_lds((const unsigned*)(K + (rowb + key0 + kg * 16 + kk) * kpitch + (2 * hp + ph) * DQK + (4 * g + c4) * 8), (LAS unsigned*)(base + (ph * NPK + kg * NG + g) * 1024), 16, 0, 0); }
        const int dd = lane >> 3;
#pragma unroll
        for (int i = 0; i < 2; ++i) { const int pi = w + 8 * i, ph = pi >> 3, blk = pi & 7; const int kp = (lane & 7) ^ (dd >> 1) ^ ((blk & 1) << 2);
            __builtin_amdgcn_global_load_lds((const unsigned*)(VT + ((size_t)((b * 8 + 2 * hp + ph) * 64 + blk * 8 + dd)) * LP + key0 + kp * 8), (LAS unsigned*)(base + KB + (ph * 8 + blk) * 1024), 16, 0, 0); }
    };
    const int kk_r = r32 & 15;
    const int koffE = (r32 >> 4) * NG * 1024 + kk_r * 64 + ((hi ^ ((kk_r >> 2) & 3)) << 4);
    const int t_r = (((r32 & 7) >> 1) ^ (((r32 >> 3) & 1) << 2));
    const int vbl = (r32 >> 3) * 1024 + (r32 & 7) * 128 + ((hi ^ (t_r & 1)) << 4), t6s = (t_r & 6) << 4;
    issue(0, 0); issue(1, 1);
    bf16x8_t qf[DQK / 16];
#pragma unroll
    for (int d0 = 0; d0 < DQK / 16; ++d0) qf[d0] = *(const bf16x8_t*)(Q + (rowb + qrow) * qpitch + head * DQK + 16 * d0 + 8 * hi);
    f32x16 o0, o1, s0, s1, n0, n1;
#pragma unroll
    for (int r = 0; r < 16; ++r) { o0[r] = 0.f; o1[r] = 0.f; }
    float lrun = 0.f;
    auto post = [&](f32x16& a0, f32x16& a1, int j) {
        const int key0 = j * 64;
        if (DSA) {
            if (q0 - (key0 + 63) < 113) {
#pragma unroll
                for (int r = 0; r < 16; ++r) { const int kk = key0 + (r & 3) + 8 * (r >> 2) + 4 * hi; int d0 = qrow - kk, d1 = d0 - 32;
                    d0 = d0 < 0 ? 0 : (d0 > 127 ? 127 : d0); d1 = d1 < 0 ? 0 : (d1 > 127 ? 127 : d1); a0[r] += lutw[d0]; a1[r] += lutw[d1]; } }
        }
        if (key0 + 63 > q0) {
#pragma unroll
            for (int r = 0; r < 16; ++r) { const int kk = key0 + (r & 3) + 8 * (r >> 2) + 4 * hi; if (kk > qrow) a0[r] = NEG_BIG; if (kk + 32 > qrow) a1[r] = NEG_BIG; }
        }
    };
#define ATT_QK(a0, a1, sl, mw_) do { const LAS unsigned char* kbase_ = lds + (sl) * BUF + hh * NPK * 1024; \
        if (DSA) { const int nlo_ = (int)~(unsigned)((mw_) >> (4 * hi)), nhi_ = (int)~(unsigned)((mw_) >> (32 + 4 * hi)); \
            _Pragma("unroll") for (int r = 0; r < 16; ++r) { const int bitp_ = (r & 3) + 8 * (r >> 2); \
                a0[r] = __int_as_float(__builtin_amdgcn_sbfe(nlo_, bitp_, 1) & __float_as_int(NEG_BIG)); a1[r] = __int_as_float(__builtin_amdgcn_sbfe(nhi_, bitp_, 1) & __float_as_int(NEG_BIG)); } } \
        else { _Pragma("unroll") for (int r = 0; r < 16; ++r) { a0[r] = 0.f; a1[r] = 0.f; } } \
        _Pragma("unroll") for (int d0 = 0; d0 < DQK / 16; ++d0) { \
            const int ko_ = ((d0 & 1) ? (koffE ^ 32) : koffE) + (d0 >> 1) * 1024; \
            const bf16x8_t k0_ = *(const LAS bf16x8_t*)(kbase_ + ko_), k1_ = *(const LAS bf16x8_t*)(kbase_ + ko_ + 2 * NG * 1024); \
            a0 = __builtin_amdgcn_mfma_f32_32x32x16_bf16(k0_, qf[d0], a0, 0, 0, 0); a1 = __builtin_amdgcn_mfma_f32_32x32x16_bf16(k1_, qf[d0], a1, 0, 0, 0); } } while (0)
#define ATT_SOFTMAX(S0_, S1_) do { float ls_ = 0.f; \
        _Pragma("unroll") for (int r = 0; r < 16; ++r) { S0_[r] = __builtin_amdgcn_exp2f(S0_[r]); S1_[r] = __builtin_amdgcn_exp2f(S1_[r]); ls_ += S0_[r] + S1_[r]; } \
        lrun += ls_; } while (0)
#define ATT_PV(S0_, S1_, sl) do { const LAS unsigned char* vbase_ = lds + (sl) * BUF + KB + hh * 8 * 1024; \
        _Pragma("unroll") for (int kb = 0; kb < 2; ++kb) _Pragma("unroll") for (int s2 = 0; s2 < 2; ++s2) { v4u pw_; \
            if (kb == 0) { pw_.x = pk2(S0_[8 * s2], S0_[8 * s2 + 1]); pw_.y = pk2(S0_[8 * s2 + 2], S0_[8 * s2 + 3]); pw_.z = pk2(S0_[8 * s2 + 4], S0_[8 * s2 + 5]); pw_.w = pk2(S0_[8 * s2 + 6], S0_[8 * s2 + 7]); } \
            else { pw_.x = pk2(S1_[8 * s2], S1_[8 * s2 + 1]); pw_.y = pk2(S1_[8 * s2 + 2], S1_[8 * s2 + 3]); pw_.z = pk2(S1_[8 * s2 + 4], S1_[8 * s2 + 5]); pw_.w = pk2(S1_[8 * s2 + 6], S1_[8 * s2 + 7]); } \
            const bf16x8_t pf_ = __builtin_bit_cast(bf16x8_t, pw_); \
            const LAS unsigned char* vp_ = vbase_ + vbl + ((32 * (2 * kb + s2)) ^ t6s); \
            const bf16x8_t v0_ = *(const LAS bf16x8_t*)vp_, v1_ = *(const LAS bf16x8_t*)(vp_ + 4096); \
            o0 = __builtin_amdgcn_mfma_f32_32x32x16_bf16(v0_, pf_, o0, 0, 0, 0); o1 = __builtin_amdgcn_mfma_f32_32x32x16_bf16(v1_, pf_, o1, 0, 0, 0); } } while (0)
    asm volatile("s_waitcnt vmcnt(0) lgkmcnt(0)" ::: "memory"); __builtin_amdgcn_s_barrier(); asm volatile("" ::: "memory");
    unsigned long long mwn = ~0ull;
    { unsigned long long mw0 = ~0ull; if (DSA) { mw0 = maskw[(size_t)b * 66 * LP + qrow]; if (NT > 1) mwn = maskw[((size_t)b * 66 + 1) * LP + qrow]; }
      ATT_QK(s0, s1, 0, mw0); post(s0, s1, 0); }
    int slot = 0;
#define ATT_STEP(S0_, S1_, N0_, N1_, jj) do { const int j_ = (jj); const int slot1 = slot == 2 ? 0 : slot + 1, slot2 = slot1 == 2 ? 0 : slot1 + 1; \
        if (j_ > 0) { asm volatile("s_waitcnt vmcnt(0) lgkmcnt(0)" ::: "memory"); __builtin_amdgcn_s_barrier(); asm volatile("" ::: "memory"); }     \
        if (j_ + 2 < NT) issue(j_ + 2, slot2); \
        const unsigned long long mw_s = mwn; \
        if (DSA) { if (j_ + 2 < NT) mwn = maskw[((size_t)b * 66 + j_ + 2) * LP + qrow]; } \
        ATT_QK(N0_, N1_, slot1, mw_s); \
        ATT_SOFTMAX(S0_, S1_); \
        ATT_PV(S0_, S1_, slot); \
        post(N0_, N1_, j_ + 1); \
        slot = slot1; } while (0)
    int j = 0;
    for (; j + 2 < NT - 1; j += 2) { ATT_STEP(s0, s1, n0, n1, j); ATT_STEP(n0, n1, s0, s1, j + 1); }
    if (j + 1 < NT) {
        ATT_STEP(s0, s1, n0, n1, j);
        ATT_SOFTMAX(n0, n1); ATT_PV(n0, n1, slot);
    } else { ATT_SOFTMAX(s0, s1); ATT_PV(s0, s1, slot); }
#undef ATT_STEP
#undef ATT_QK
#undef ATT_SOFTMAX
#undef ATT_PV
    lrun += __shfl_xor(lrun, 32);
    const float inv = 1.0f / lrun;
    bf16_t* op = O + (rowb + qrow) * D + head * 64 + 4 * hi;
#pragma unroll
    for (int g = 0; g < 4; ++g) {
        v2u a, bq; a.x = pk2(o0[4 * g] * inv, o0[4 * g + 1] * inv); a.y = pk2(o0[4 * g + 2] * inv, o0[4 * g + 3] * inv);
        bq.x = pk2(o1[4 * g] * inv, o1[4 * g + 1] * inv); bq.y = pk2(o1[4 * g + 2] * inv, o1[4 * g + 3] * inv);
        *(v2u*)(op + 8 * g) = a; *(v2u*)(op + 32 + 8 * g) = bq; }
    asm volatile("s_waitcnt vmcnt(0) lgkmcnt(0)" ::: "memory"); __builtin_amdgcn_s_barrier(); asm volatile("" ::: "memory");
}
template <int DQK, bool DSA>
DI void attn_unit2(LAS unsigned char* lds, int b, int qt, int hp, const bf16_t* Q, int qpitch, const bf16_t* K, int kpitch, const bf16_t* VT, bf16_t* O,
                   const unsigned long long* maskw, const float* lut) {
    constexpr int NPK = DQK / 8, KB = 2 * NPK * 1024, BUF = KB + 16 * 1024;
    int tid_ = threadIdx.x; asm volatile("" : "+v"(tid_));
    const int tid = tid_, lane = tid & 63, w = __builtin_amdgcn_readfirstlane(tid >> 6), r32 = lane & 31, hi = lane >> 5;
    const int hh = w >> 2, head = 2 * hp + hh, q0 = qt * 256 + (w & 3) * 64;
    const bool live = q0 < LP;
    const int qrowA = live ? q0 + r32 : r32, qrowB = qrowA + 32;
    const size_t rowb = (size_t)b * LP;
    const int NT = (4 * qt + 4) < (LP / 64) ? (4 * qt + 4) : (LP / 64);
    if (DSA) { if (tid < 256) ((LAS float*)(lds + ATT_LUT_OFF))[tid] = lut[(tid & 127) * 8 + 2 * hp + (tid >> 7)] - lut[127 * 8 + 2 * hp + (tid >> 7)]; }
    const LAS float* lutw = (const LAS float*)(lds + ATT_LUT_OFF) + hh * 128;
    if (DSA) { if (tid < 64) ((LAS float*)(lds + ATT_LUT_OFF + 1024))[tid] = (((tid >> 2) >> (tid & 3)) & 1) ? 0.f : NEG_BIG; }
    const LAS unsigned char* mtab = lds + ATT_LUT_OFF + 1024;
    constexpr int NG = NPK / 4;
    auto issue = [&](int j, int buf) {
        const int key0 = j * 64; LAS unsigned char* base = lds + buf * BUF;
        const int kk = lane >> 2, c4 = (lane & 3) ^ ((kk >> 2) & 3);
#pragma unroll
        for (int i = 0; i < 2 * NPK / 8; ++i) { const int pi = w + 8 * i, ph = pi / NPK, rem = pi % NPK, kg = rem / NG, g = rem % NG;
            __builtin_amdgcn_global_load_lds((const unsigned*)(K + (rowb + key0 + kg * 16 + kk) * kpitch + (2 * hp + ph) * DQK + (4 * g + c4) * 8), (LAS unsigned*)(base + (ph * NPK + kg * NG + g) * 1024), 16, 0, 0); }
        const int dd = lane >> 3;
#pragma unroll
        for (int i = 0; i < 2; ++i) { const int pi = w + 8 * i, ph = pi >> 3, blk = pi & 7; const int kp = (lane & 7) ^ (dd >> 1) ^ ((blk & 1) << 2);
            __builtin_amdgcn_global_load_lds((const unsigned*)(VT + ((size_t)((b * 8 + 2 * hp + ph) * 64 + blk * 8 + dd)) * LP + key0 + kp * 8), (LAS unsigned*)(base + KB + (ph * 8 + blk) * 1024), 16, 0, 0); }
    };
    const int kk_r = r32 & 15;
    const int koffE = (r32 >> 4) * NG * 1024 + kk_r * 64 + ((hi ^ ((kk_r >> 2) & 3)) << 4);
    const int t_r = (((r32 & 7) >> 1) ^ (((r32 >> 3) & 1) << 2));
    const int vbl = (r32 >> 3) * 1024 + (r32 & 7) * 128 + ((hi ^ (t_r & 1)) << 4), t6s = (t_r & 6) << 4;
    issue(0, 0); issue(1, 1);
    bf16x8_t qfA[DQK / 16], qfB[DQK / 16];
#pragma unroll
    for (int d0 = 0; d0 < DQK / 16; ++d0) { qfA[d0] = *(const bf16x8_t*)(Q + (rowb + qrowA) * qpitch + head * DQK + 16 * d0 + 8 * hi); qfB[d0] = *(const bf16x8_t*)(Q + (rowb + qrowB) * qpitch + head * DQK + 16 * d0 + 8 * hi); }
    f32x16 oA0, oA1, oB0, oB1, sA0, sA1, sB0, sB1;
#pragma unroll
    for (int r = 0; r < 16; ++r) { oA0[r] = 0.f; oA1[r] = 0.f; oB0[r] = 0.f; oB1[r] = 0.f; }
    float lA = 0.f, lB = 0.f;
    auto post = [&](f32x16& a0, f32x16& a1, int key0, int qb, int qr) {
        if (DSA) {
            if (qb - (key0 + 63) < 113) {
#pragma unroll
                for (int r = 0; r < 16; ++r) { const int kk = key0 + (r & 3) + 8 * (r >> 2) + 4 * hi; int d0 = qr - kk, d1 = d0 - 32;
                    d0 = d0 < 0 ? 0 : (d0 > 127 ? 127 : d0); d1 = d1 < 0 ? 0 : (d1 > 127 ? 127 : d1); a0[r] += lutw[d0]; a1[r] += lutw[d1]; } }
        }
        if (key0 + 63 > qb) {
#pragma unroll
            for (int r = 0; r < 16; ++r) { const int kk = key0 + (r & 3) + 8 * (r >> 2) + 4 * hi; if (kk > qr) a0[r] = NEG_BIG; if (kk + 32 > qr) a1[r] = NEG_BIG; }
        }
    };
#define ATT2_INIT(a0, a1, mw_) do { if (DSA) { const unsigned mlo_ = (unsigned)((mw_) >> (4 * hi)), mhi_ = (unsigned)((mw_) >> (32 + 4 * hi)); \
            _Pragma("unroll") for (int g = 0; g < 4; ++g) { const f32x4 t0_ = *(const LAS f32x4*)(mtab + ((mlo_ >> (8 * g)) & 15u) * 16), t1_ = *(const LAS f32x4*)(mtab + ((mhi_ >> (8 * g)) & 15u) * 16); \
                a0[4 * g] = t0_.x; a0[4 * g + 1] = t0_.y; a0[4 * g + 2] = t0_.z; a0[4 * g + 3] = t0_.w; a1[4 * g] = t1_.x; a1[4 * g + 1] = t1_.y; a1[4 * g + 2] = t1_.z; a1[4 * g + 3] = t1_.w; } } \
        else { _Pragma("unroll") for (int r = 0; r < 16; ++r) { a0[r] = 0.f; a1[r] = 0.f; } } } while (0)
#define ATT2_EXP(S0_, S1_, L_) do { f32x2_t l2_ = {0.f, 0.f}; \
        _Pragma("unroll") for (int r = 0; r < 16; ++r) { S0_[r] = __builtin_amdgcn_exp2f(S0_[r]); S1_[r] = __builtin_amdgcn_exp2f(S1_[r]); } \
        _Pragma("unroll") for (int r = 0; r < 16; r += 2) { l2_ += (f32x2_t){S0_[r], S0_[r + 1]}; l2_ += (f32x2_t){S1_[r], S1_[r + 1]}; }     \
        L_ += l2_.x + l2_.y; } while (0)
#define ATT2_PACK(S_, s2) ({ v4u pw_; pw_.x = pk2(S_[8 * (s2)], S_[8 * (s2) + 1]); pw_.y = pk2(S_[8 * (s2) + 2], S_[8 * (s2) + 3]); pw_.z = pk2(S_[8 * (s2) + 4], S_[8 * (s2) + 5]); pw_.w = pk2(S_[8 * (s2) + 6], S_[8 * (s2) + 7]); __builtin_bit_cast(bf16x8_t, pw_); })
    asm volatile("s_waitcnt vmcnt(0) lgkmcnt(0)" ::: "memory"); __builtin_amdgcn_s_barrier(); asm volatile("" ::: "memory");
    unsigned long long mwA = ~0ull, mwB = ~0ull;
    if (DSA && live) { mwA = maskw[(size_t)b * 66 * LP + qrowA]; mwB = maskw[(size_t)b * 66 * LP + qrowB]; }
    int slot = 0;
    for (int j = 0; j < NT; ++j) {
        const int slot1 = slot == 2 ? 0 : slot + 1, slot2 = slot1 == 2 ? 0 : slot1 + 1;
        if (j > 0) { asm volatile("s_waitcnt vmcnt(0) lgkmcnt(0)" ::: "memory"); __builtin_amdgcn_s_barrier(); asm volatile("" ::: "memory"); }
        if (j + 2 < NT) issue(j + 2, slot2);
        const unsigned long long mA = mwA, mB = mwB;
        if (DSA && live && j + 1 < NT) { mwA = maskw[((size_t)b * 66 + j + 1) * LP + qrowA]; mwB = maskw[((size_t)b * 66 + j + 1) * LP + qrowB]; }
        const int key0 = j * 64;
        if (live && key0 <= q0 + 63) {
            ATT2_INIT(sA0, sA1, mA); ATT2_INIT(sB0, sB1, mB);
            { const LAS unsigned char* kbase_ = lds + slot * BUF + hh * NPK * 1024;
#pragma unroll
              for (int d0 = 0; d0 < DQK / 16; ++d0) {
                  const int ko_ = ((d0 & 1) ? (koffE ^ 32) : koffE) + (d0 >> 1) * 1024;
                  const bf16x8_t k0_ = *(const LAS bf16x8_t*)(kbase_ + ko_), k1_ = *(const LAS bf16x8_t*)(kbase_ + ko_ + 2 * NG * 1024);
                  sA0 = __builtin_amdgcn_mfma_f32_32x32x16_bf16(k0_, qfA[d0], sA0, 0, 0, 0); sA1 = __builtin_amdgcn_mfma_f32_32x32x16_bf16(k1_, qfA[d0], sA1, 0, 0, 0);
                  sB0 = __builtin_amdgcn_mfma_f32_32x32x16_bf16(k0_, qfB[d0], sB0, 0, 0, 0); sB1 = __builtin_amdgcn_mfma_f32_32x32x16_bf16(k1_, qfB[d0], sB1, 0, 0, 0); } }
            post(sA0, sA1, key0, q0, qrowA); ATT2_EXP(sA0, sA1, lA);
            post(sB0, sB1, key0, q0 + 32, qrowB); ATT2_EXP(sB0, sB1, lB);
            { const LAS unsigned char* vbase_ = lds + slot * BUF + KB + hh * 8 * 1024;
#pragma unroll
              for (int kb = 0; kb < 2; ++kb)
#pragma unroll
                  for (int s2 = 0; s2 < 2; ++s2) {
                      const bf16x8_t pA_ = kb == 0 ? ATT2_PACK(sA0, s2) : ATT2_PACK(sA1, s2), pB_ = kb == 0 ? ATT2_PACK(sB0, s2) : ATT2_PACK(sB1, s2);
                      const LAS unsigned char* vp_ = vbase_ + vbl + ((32 * (2 * kb + s2)) ^ t6s);
                      const bf16x8_t v0_ = *(const LAS bf16x8_t*)vp_, v1_ = *(const LAS bf16x8_t*)(vp_ + 4096);
                      oA0 = __builtin_amdgcn_mfma_f32_32x32x16_bf16(v0_, pA_, oA0, 0, 0, 0); oA1 = __builtin_amdgcn_mfma_f32_32x32x16_bf16(v1_, pA_, oA1, 0, 0, 0);
                      oB0 = __builtin_amdgcn_mfma_f32_32x32x16_bf16(v0_, pB_, oB0, 0, 0, 0); oB1 = __builtin_amdgcn_mfma_f32_32x32x16_bf16(v1_, pB_, oB1, 0, 0, 0); } }
        }
        slot = slot1;
    }
#undef ATT2_INIT
#undef ATT2_EXP
#undef ATT2_PACK
    if (live) {
        lA += __shfl_xor(lA, 32); lB += __shfl_xor(lB, 32);
        const float invA = 1.0f / lA, invB = 1.0f / lB;
        bf16_t* opA = O + (rowb + qrowA) * D + head * 64 + 4 * hi; bf16_t* opB = O + (rowb + qrowB) * D + head * 64 + 4 * hi;
#pragma unroll
        for (int g = 0; g < 4; ++g) {
            v2u a, bq; a.x = pk2(oA0[4 * g] * invA, oA0[4 * g + 1] * invA); a.y = pk2(oA0[4 * g + 2] * invA, oA0[4 * g + 3] * invA);
            bq.x = pk2(oA1[4 * g] * invA, oA1[4 * g + 1] * invA); bq.y = pk2(oA1[4 * g + 2] * invA, oA1[4 * g + 3] * invA);
            *(v2u*)(opA + 8 * g) = a; *(v2u*)(opA + 32 + 8 * g) = bq;
            a.x = pk2(oB0[4 * g] * invB, oB0[4 * g + 1] * invB); a.y = pk2(oB0[4 * g + 2] * invB, oB0[4 * g + 3] * invB);
            bq.x = pk2(oB1[4 * g] * invB, oB1[4 * g + 1] * invB); bq.y = pk2(oB1[4 * g + 2] * invB, oB1[4 * g + 3] * invB);
            *(v2u*)(opB + 8 * g) = a; *(v2u*)(opB + 32 + 8 * g) = bq; }
    }
    asm volatile("s_waitcnt vmcnt(0) lgkmcnt(0)" ::: "memory"); __builtin_amdgcn_s_barrier(); asm volatile("" ::: "memory");
}
template <int DQK, bool DSA>
DI void attn_phase2(const Ctx& c, const bf16_t* Q, int qpitch, const bf16_t* K, int kpitch, const bf16_t* VT, bf16_t* O, const unsigned long long* maskw, const float* lut,
                    unsigned* ticket, volatile LAS unsigned* misc) {
    constexpr int NLV = (LP + 255) / 256, NU = NB * NLV * 4;
    int par = 0;
    for (unsigned u = (unsigned)c.bid; u < (unsigned)NU; ) {
        unsigned nu = 0u; if (c.tid == 0) nu = (unsigned)c.G + __hip_atomic_fetch_add(ticket, 1u, RLX_AGENT);
        const int qt = NLV - 1 - (int)(u / 32u), b = (int)(u % 32u) >> 2, hp = (int)(u & 3u);
        attn_unit2<DQK, DSA>((LAS unsigned char*)c.lds, b, qt, hp, Q, qpitch, K, kpitch, VT, O, maskw, lut);
        par ^= 1; if (c.tid == 0) misc[26 + par] = nu;
        asm volatile("s_waitcnt vmcnt(0) lgkmcnt(0)" ::: "memory"); __builtin_amdgcn_s_barrier(); asm volatile("" ::: "memory");
        u = misc[26 + par];
    }
}
template <int DQK, bool DSA>
DI void attn_phase(const Ctx& c, const bf16_t* Q, int qpitch, const bf16_t* K, int kpitch, const bf16_t* VT, bf16_t* O, const unsigned long long* maskw, const float* lut) {
    constexpr int NU = NB * 33 * 4;
    for (int rnd = 0;; ++rnd) {
        const int u = rnd * c.G + ((rnd & 1) ? (c.G - 1 - c.bid) : c.bid); if (u >= NU) { if (rnd * c.G >= NU) break; else continue; }
        const int qt = 32 - u / 32, b = (u % 32) >> 2, hp = u & 3;
        attn_unit<DQK, DSA>((LAS unsigned char*)c.lds, b, qt, hp, Q, qpitch, K, kpitch, VT, O, maskw, lut);
    }
}

enum { PH_PROLOGUE = 0, PH_MIXIN, PH_UP, PH_EW4, PH_ATTN, PH_MIXOUT, PH_NORM1, PH_FFN1, PH_FFN2, PH_NORM2, PH_WIN, PH_CONV, PH_WOUT, PH_ROUTE, PH_SCATTER, PH_MOE1A, PH_MOE2A, PH_MOE1B, PH_MOE2B, PH_FIX, NPH };

__global__ void __launch_bounds__(512, 2) mk_fwd(Args args) {
    extern __shared__ __attribute__((aligned(16))) unsigned char lds_raw[];
    Ctx c;
    c.tid = threadIdx.x; c.lane = c.tid & 63; c.wave = __builtin_amdgcn_readfirstlane(c.tid >> 6);
    c.G = gridDim.x; c.bid = blockIdx.x; c.gw = c.bid * 8 + c.wave; c.ngw = c.G * 8;
    c.lds = lds_raw; c.wscr = lds_raw + c.wave * WSCR;
    unsigned char* ws = args.ws; unsigned char* ob = (unsigned char*)args.out;
    gu32* ctl = (gu32*)(ws + WS_CTL);
    volatile LAS unsigned* MISC = (volatile LAS unsigned*)((LAS unsigned char*)lds_raw + MISC_OFF);
    if (c.tid < 32) MISC[c.tid] = 0u;
    __syncthreads();
#if MK_ONE_LAUNCH
    XcdBarrier bar = xcd_barrier_post((unsigned*)(ws + WS_CTL) + CW_BAR, MISC + 8);
#define GRID_BAR() xcd_barrier(bar)
#else
#define GRID_BAR() do {} while (0)
#endif
    const int lo = args.ph_lo, hi = args.ph_hi;
#ifdef ONLY_PH
#define IN(k) ((k) == ONLY_PH && lo <= (k) && (k) < hi)
#else
#define IN(k) (lo <= (k) && (k) < hi)
#endif
#define SEAM(k) do { if (IN(k) && IN((k) + 1)) GRID_BAR(); } while (0)
    const float* const* in = args.in;
#define WSP(T, off) ((T*)(ws + (off)))
#define CNT (((unsigned*)(ws + WS_CTL)) + CW_CNT)

    if (IN(PH_PROLOGUE)) {
        conv_matrix(c, SrcMix{in[4]}, D, MIXN, WSP(bf16_t, WS_WMIX));
        conv_matrix(c, SrcPlainG{in[7], 768, in[5]}, QR, 768, WSP(bf16_t, WS_WUQ));
        conv_matrix(c, SrcPlainG{in[8], 1024, in[6]}, KVR, 1024, WSP(bf16_t, WS_WUKV));
        { int rot = 0;
        conv_fast<false>(c, RowPlain{in[13], D}, D, D, WSP(bf16_t, WS_WMO), 1.f, rot);
        conv_fast<false>(c, RowGlu{in[15], in[16], DFF}, D, 2 * DFF, WSP(bf16_t, WS_W13), 1.f, rot);
        conv_fast<false>(c, RowPlain{in[17], D}, DFF, D, WSP(bf16_t, WS_W2), 1.f, rot);
        conv_fast<false>(c, RowGlu{in[19] + 1024, in[19] + 2048, 3072}, D, 2048, WSP(bf16_t, WS_WIN), 1.f, rot);
        conv_fast<false>(c, RowPlain{in[19], 3072}, D, 1024, WSP(bf16_t, WS_WIN) + (size_t)2048 * D, 1.f, rot);
        conv_fast<false>(c, RowPlain{in[21], D}, D, D, WSP(bf16_t, WS_WOUT), 1.f, rot); }
        if (c.bid == 0) { float* lut = WSP(float, TAB_LUT); for (int i = c.tid; i < 1024; i += 512) { const int d = i >> 3, hh = i & 7; int bk;
            if (d < 16) bk = d; else { bk = 16; const int th[15] = {19, 21, 24, 27, 31, 35, 40, 46, 52, 59, 67, 77, 87, 99, 113};
#pragma unroll
                for (int k = 0; k < 15; ++k) bk += (d >= th[k]) ? 1 : 0; }
            lut[i] = in[2][bk * 8 + hh] * LOG2E; } }
        phase_prologue_rows(c, in[0], in[1], in[3], WSP(bf16_t, WS_H), WSP(bf16_t, WS_XN));
    }
    SEAM(PH_PROLOGUE);
    if (IN(PH_MIXIN)) {
        GemmP g{WSP(bf16_t, WS_XN), D, nullptr, D, D}; StaticSched S; S.init(MP / 256, MIXN / 256, c.G, c.bid, WSP(bf16_t, WS_WMIX), D, 0);
        gemm_phase<false>(c, g, S, EpiRoute{ws, in[11], in[12]});
        { int w, nw; if (idle_slot(c, NWG_MIXIN, w, nw)) moe_conv_items<0>(c, in, ws, 0, idle_items(c.G, NWG_MIXIN, NE * MOE_IT13), w, nw); }
    }
    SEAM(PH_MIXIN);
    if (IN(PH_UP)) {
        for (int q = 0; q < 2; ++q) {
            GemmP g{WSP(bf16_t, WS_LAT) + (q == 0 ? 256 : 0), 768, nullptr, q == 0 ? QR : KVR, q == 0 ? QR : KVR};
            StaticSched S; S.init(MP / 256, q == 0 ? 3 : 4, c.G, c.bid, q == 0 ? WSP(bf16_t, WS_WUQ) : WSP(bf16_t, WS_WUKV), q == 0 ? QR : KVR, 0);
            gemm_phase<false>(c, g, S, EpiUp{(bf16_t*)(ob + (q == 0 ? OUT_QM : OUT_KV)), q == 0 ? MLAW : 1024, WSP(float, WS_SSP), q == 0 ? 1 : 0});
        }
        phase_select(c, WSP(bf16_t, WS_IQ), WSP(bf16_t, WS_IWC), WSP(bf16_t, WS_IKC), WSP(unsigned long long, WS_MASK), ((unsigned*)(ws + WS_CTL)) + CW_SEL, MISC);
    }
    SEAM(PH_UP);
    if (IN(PH_EW4)) {
        phase_ew4(c, (bf16_t*)(ob + OUT_QM), (const bf16_t*)(ob + OUT_KV), WSP(bf16_t, WS_LAT), WSP(bf16_t, WS_LAT), in[9], in[10]);
        transpose_v(c, (const bf16_t*)(ob + OUT_KV), 1024, 64, 128, WSP(bf16_t, WS_VMT)); transpose_v(c, WSP(bf16_t, WS_DV), 512, 0, 64, WSP(bf16_t, WS_VDT)); }
    SEAM(PH_EW4);
    if (IN(PH_ATTN)) {
#if NAIVE_ATTN
        phase_mla_naive(c, (const bf16_t*)(ob + OUT_QM), WSP(bf16_t, WS_LAT), WSP(bf16_t, WS_VMT), WSP(bf16_t, WS_XN));
        phase_dsa_naive(c, WSP(bf16_t, WS_DQ), WSP(bf16_t, WS_DK), WSP(bf16_t, WS_DV), WSP(bf16_t, WS_IQ), WSP(bf16_t, WS_IK), WSP(float, WS_IW), WSP(float, TAB_LUT), WSP(bf16_t, WS_XN));
#else
        attn_phase2<96, false>(c, (const bf16_t*)(ob + OUT_QM), MLAW, WSP(bf16_t, WS_LAT), MLAW, WSP(bf16_t, WS_VMT), WSP(bf16_t, WS_XN), nullptr, nullptr, ((unsigned*)(ws + WS_CTL)) + CW_ATT, MISC);
        attn_phase2<64, true>(c, WSP(bf16_t, WS_DQ), DW, WSP(bf16_t, WS_DK), DW, WSP(bf16_t, WS_VDT), WSP(bf16_t, WS_XN) + 512, WSP(unsigned long long, WS_MASK), WSP(float, TAB_LUT), ((unsigned*)(ws + WS_CTL)) + CW_ATT + 1, MISC);
#endif
    }
    SEAM(PH_ATTN);
    if (IN(PH_MIXOUT)) { GemmP g{WSP(bf16_t, WS_XN), D, nullptr, D, D}; StaticSched S; S.init(MP / 256, 4, c.G, c.bid, WSP(bf16_t, WS_WMO), D, CAP_A); gemm_phase<false>(c, g, S, EpiResid{WSP(bf16_t, WS_H), WSP(bf16_t, WS_H), 0, WSP(float, WS_PART_A)}); }
    SEAM(PH_MIXOUT);
    if (IN(PH_NORM1)) { StaticSched S; S.init(MP / 256, 4, c.G, c.bid, nullptr, D, CAP_A); phase_norm_rows(c, WSP(bf16_t, WS_H), in[14], WSP(bf16_t, WS_XN), MP, S, WSP(float, WS_PART_A)); }
    SEAM(PH_NORM1);
    if (IN(PH_FFN1)) { GemmP g{WSP(bf16_t, WS_XN), D, nullptr, D, D}; StaticSched S; S.init(MP / 256, 2 * DFF / 256, c.G, c.bid, WSP(bf16_t, WS_W13), D, 0); gemm_phase<false>(c, g, S, EpiGlu{WSP(bf16_t, WS_HF), DFF});
        { int w, nw; const int a0 = idle_items(c.G, NWG_MIXIN, NE * MOE_IT13); if (idle_slot(c, NWG_FFN1, w, nw)) moe_conv_items<0>(c, in, ws, a0, a0 + idle_items(c.G, NWG_FFN1, NE * MOE_IT13 - a0), w, nw); } }
    SEAM(PH_FFN1);
    if (IN(PH_FFN2)) { GemmP g{WSP(bf16_t, WS_HF), DFF, nullptr, DFF, DFF}; StaticSched S; S.init(MP / 256, 4, c.G, c.bid, WSP(bf16_t, WS_W2), DFF, CAP_F); gemm_phase<false>(c, g, S, EpiResid{WSP(bf16_t, WS_H), WSP(bf16_t, WS_H), 0, WSP(float, WS_PART_F)}); }
    SEAM(PH_FFN2);
    if (IN(PH_NORM2)) { StaticSched S; S.init(MP / 256, 4, c.G, c.bid, nullptr, DFF, CAP_F); phase_norm_rows(c, WSP(bf16_t, WS_H), in[18], WSP(bf16_t, WS_XN), MP, S, WSP(float, WS_PART_F)); }
    SEAM(PH_NORM2);
    if (IN(PH_WIN)) { GemmP g{WSP(bf16_t, WS_XN), D, nullptr, D, D}; StaticSched S; S.init(MP / 256, 12, c.G, c.bid, WSP(bf16_t, WS_WIN), D, 0); gemm_phase<false>(c, g, S, EpiConvIn{WSP(bf16_t, WS_Z)});
        { int w, nw; if (idle_slot(c, NWG_WIN, w, nw)) moe_conv_items<1>(c, in, ws, 0, idle_items(c.G, NWG_WIN, NE * MOE_IT2), w, nw); } }
    SEAM(PH_WIN);
    if (IN(PH_CONV)) phase_conv(c, WSP(bf16_t, WS_Z), in[20], WSP(bf16_t, WS_XN));
    SEAM(PH_CONV);
    if (IN(PH_WOUT)) { GemmP g{WSP(bf16_t, WS_XN), D, nullptr, D, D}; StaticSched S; S.init(MR / 256, 4, c.G, c.bid, WSP(bf16_t, WS_WOUT), D, 0); gemm_phase<false>(c, g, S, EpiResid{WSP(bf16_t, WS_H), WSP(bf16_t, WS_H3B), 1, nullptr}); }
    SEAM(PH_WOUT);
    if (IN(PH_ROUTE)) {
        { const int a0 = idle_items(c.G, NWG_MIXIN, NE * MOE_IT13), d13 = a0 + idle_items(c.G, NWG_FFN1, NE * MOE_IT13 - a0), d2 = idle_items(c.G, NWG_WIN, NE * MOE_IT2);
          const int r13 = NE * MOE_IT13 - d13;
          moe_conv_items<0>(c, in, ws, d13, NE * MOE_IT13, c.gw, c.ngw);
          int w2 = (c.gw - r13 % c.ngw) % c.ngw; if (w2 < 0) w2 += c.ngw;
          moe_conv_items<1>(c, in, ws, d2, NE * MOE_IT2, w2, c.ngw); }
        { int* rowtok = WSP(int, TAB_ROWTOK); for (int i = c.bid * 512 + c.tid; i < 2 * MOE_ROWS; i += c.G * 512) rowtok[i] = -1; }
        phase_route(c, WSP(bf16_t, WS_H3B), in[22], in[23], WSP(unsigned char, WS_XN2), CNT, WSP(int, TAB_ASG), WSP(float, TAB_GATE));
    }
    SEAM(PH_ROUTE);
    if (IN(PH_SCATTER)) phase_scatter(c, CNT, WSP(int, TAB_ASG), WSP(float, TAB_GATE), WSP(int, TAB_ROWTOK), WSP(float, TAB_ROWGATE));
    SEAM(PH_SCATTER);
#pragma unroll
    for (int s = 0; s < 2; ++s) {
        if (IN(PH_MOE1A + 2 * s)) {
            if (s == 1) { MoeSched<4> S2; S2.init(CNT, c.G, c.bid, nullptr, 0, DFF / 2, CAP_M);
                phase_moe_fix<4, 0>(c, S2, WSP(int, TAB_ROWTOK), WSP(float, TAB_ROWGATE), WSP(float, WS_PART_M), args.out, 1.f / (F8_SH * F8_SW2), WSP(bf16_t, WS_PARTA), WSP(bf16_t, WS_H3B)); }
            GemmP g{WSP(bf16_t, WS_XN2), D / 2, WSP(int, TAB_ROWTOK) + s * MOE_ROWS, D / 2, D / 2}; MoeSched<2 * DFF / 256> S; S.init(CNT + 8 * s, c.G, c.bid, WSP(bf16_t, WS_MW13), (size_t)DFF * D, D / 2, 0);
            gemm_phase<true, true>(c, g, S, EpiGlu8{WSP(unsigned char, WS_HM), DFF}); }
        SEAM(PH_MOE1A + 2 * s);
        if (IN(PH_MOE2A + 2 * s)) { GemmP g{WSP(bf16_t, WS_HM), DFF / 2, nullptr, DFF / 2, DFF / 2}; MoeSched<4> S; S.init(CNT + 8 * s, c.G, c.bid, WSP(bf16_t, WS_MW2), (size_t)D * DFF / 2, DFF / 2, CAP_M);
            if (s == 0) gemm_phase<false, true>(c, g, S, EpiMoe2<0>{WSP(int, TAB_ROWTOK), WSP(float, TAB_ROWGATE), args.out, WSP(float, WS_PART_M), 1.f / (F8_SH * F8_SW2), WSP(bf16_t, WS_PARTA), WSP(bf16_t, WS_H3B)});
            else gemm_phase<false, true>(c, g, S, EpiMoe2<1>{WSP(int, TAB_ROWTOK) + MOE_ROWS, WSP(float, TAB_ROWGATE) + MOE_ROWS, args.out, WSP(float, WS_PART_M), 1.f / (F8_SH * F8_SW2), WSP(bf16_t, WS_PARTA), WSP(bf16_t, WS_H3B)}); }
        SEAM(PH_MOE2A + 2 * s);
    }
    if (IN(PH_FIX)) { MoeSched<4> S2; S2.init(CNT + 8, c.G, c.bid, nullptr, 0, DFF / 2, CAP_M);
        phase_moe_fix<4, 1>(c, S2, WSP(int, TAB_ROWTOK) + MOE_ROWS, WSP(float, TAB_ROWGATE) + MOE_ROWS, WSP(float, WS_PART_M), args.out, 1.f / (F8_SH * F8_SW2), WSP(bf16_t, WS_PARTA), WSP(bf16_t, WS_H3B)); }
}

extern "C" void kernel_launch(void* const* d_in, const int* in_sizes, int n_in, void* d_out, int out_size, void* d_ws, size_t ws_size, hipStream_t stream) {
    static int grid = 0;
    if (grid == 0) {
        if (n_in != 27 || out_size != MR * D || ws_size < WS_END) { fprintf(stderr, "kernel_launch: unexpected problem (n_in %d out %d ws %zu)\n", n_in, out_size, ws_size); grid = -1; return; }
        int dev = 0, cus = 0;
        if (hipGetDevice(&dev) != hipSuccess || hipDeviceGetAttribute(&cus, hipDeviceAttributeMultiprocessorCount, dev) != hipSuccess) { grid = -1; return; }
        if (hipFuncSetAttribute((const void*)mk_fwd, hipFuncAttributeMaxDynamicSharedMemorySize, LDS_BYTES) != hipSuccess) { grid = -1; return; }
        int per_cu = 0;
        if (hipOccupancyMaxActiveBlocksPerMultiprocessor(&per_cu, (const void*)mk_fwd, 512, LDS_BYTES) != hipSuccess || per_cu < 1) { fprintf(stderr, "kernel_launch: occupancy query says %d\n", per_cu); }
        (void)hipGetLastError();
        grid = cus;
    }
    if (grid < 0) return;
    (void)hipMemsetAsync((char*)d_ws + WS_CTL, 0, CTL_ZERO_BYTES, stream);
    Args a{};
    for (int i = 0; i < 27; ++i) a.in[i] = (const float*)d_in[i];
    a.out = (float*)d_out; a.ws = (unsigned char*)d_ws;
#if MK_ONE_LAUNCH
    a.ph_lo = 0; a.ph_hi = NPH;
    hipLaunchKernelGGL(mk_fwd, dim3(grid), dim3(512), LDS_BYTES, stream, a);
#else
    for (int p = 0; p < NPH; ++p) { a.ph_lo = p; a.ph_hi = p + 1; hipLaunchKernelGGL(mk_fwd, dim3(grid), dim3(512), LDS_BYTES, stream, a); }
#endif
}
```
